# Optimizing an MI355X kernel written in HIP

```python
import numpy as np
import jax
import jax.numpy as jnp
from jax import lax

D_MODEL = 1024
BATCH = 8
SEQ = 2048
DEPTH = 1
DEC_BATCH = 8
DEC_SEQ = 32
PAST_LEN = 4096

CHUNK = 64
N_MEM = 256
EPS = 1e-6
A_HEADS = 4
A_HEAD_DIM = 128
A_WIDTH = A_HEADS * A_HEAD_DIM
B_WIDTH = D_MODEL
B_BLOCKS = 16
B_BLOCK_DIM = B_WIDTH // B_BLOCKS
CONV_W = 4
LRU_C = 8.0
C_HEADS = 4
C_HEAD_DIM = 128
C_WIDTH = C_HEADS * C_HEAD_DIM
N_BRANCH = 3
IN_COLS = 4 * A_WIDTH + 2 * B_WIDTH + 2 * C_WIDTH + N_BRANCH * D_MODEL

kernel_name = 'hybrid_hgrn2_rglru_memxattn_stream_step'


def _rmsnorm(x, g):
    xf = x.astype(jnp.float32)
    y = xf * lax.rsqrt(jnp.mean(xf * xf, axis=-1, keepdims=True) + EPS) * g.astype(jnp.float32)
    return y.astype(x.dtype)


def _hgrn2(q, logf, k, v, s0):
    bsz, seq, nh, _ = q.shape
    dv = v.shape[-1]
    c = min(CHUNK, seq)
    n = seq // c

    def blocks(t):
        return t.reshape(bsz, n, c, nh, t.shape[-1]).transpose(1, 0, 3, 2, 4)

    mask = jnp.tril(jnp.ones((c, c), dtype=bool))

    def step(s, inp):
        qc, lc, kc, vc = inp
        b = jnp.cumsum(lc, axis=2)
        qg = qc * jnp.exp(b)
        kg = kc * jnp.exp(-b)
        att = jnp.where(mask, jnp.einsum('bhtk,bhsk->bhts', qg, kg), 0.0)
        o = jnp.einsum('bhts,bhsv->bhtv', att, vc) + jnp.einsum('bhtk,bhkv->bhtv', qg, s)
        b_last = b[:, :, -1:, :]
        s = jnp.exp(b_last[:, :, 0, :])[..., None] * s + jnp.einsum('bhsk,bhsv->bhkv', kc * jnp.exp(b_last - b), vc)
        return s, o

    s_last, o = lax.scan(step, s0, (blocks(q), blocks(logf), blocks(k), blocks(v)))
    o = o.transpose(1, 0, 3, 2, 4).reshape(bsz, seq, nh, dv)
    return o, s_last


def _lru_scan(a, u, h0):
    u = u.at[:, 0].add(a[:, 0] * h0)

    def comb(left, right):
        al, ul = left
        ar, ur = right
        return al * ar, ar * ul + ur

    _, hs = lax.associative_scan(comb, (a, u), axis=1)
    return hs, hs[:, -1]


def _memory_kv(mem, g_mem, w_mem_k, w_mem_v):
    bsz = mem.shape[0]
    hm = _rmsnorm(mem, g_mem)
    mk = (hm @ w_mem_k).reshape(bsz, N_MEM, C_HEADS, C_HEAD_DIM)
    mv = (hm @ w_mem_v).reshape(bsz, N_MEM, C_HEADS, C_HEAD_DIM)
    return mk, mv


def _mixer_layer(x, mem_k, mem_v, s_hgrn, conv_ctx, h_lru, first_is_start, lb,
                 g_mix, w_in, g_a_out, w_a_down, w_conv, b_conv, w_lru_r, b_lru_r,
                 w_lru_i, b_lru_i, lru_lambda, w_b_down, w_c_down, w_out):
    f32 = jnp.float32
    bsz, seq, _ = x.shape
    h = _rmsnorm(x, g_mix)
    z = h @ w_in
    sizes = (A_WIDTH, A_WIDTH, A_WIDTH, A_WIDTH, B_WIDTH, B_WIDTH, C_WIDTH, C_WIDTH, D_MODEL, D_MODEL, D_MODEL)
    offs = [int(o) for o in np.cumsum(sizes)[:-1]]
    qa, fa, va, ga, xb, gb, qc, gc, za, zb, zc = jnp.split(z, offs, axis=-1)

    head4 = (bsz, seq, A_HEADS, A_HEAD_DIM)
    f = lb + (1.0 - lb) * jax.nn.sigmoid(fa.astype(f32))
    oa, s_hgrn_new = _hgrn2(jax.nn.silu(qa.astype(f32)).reshape(head4), jnp.log(f).reshape(head4),
                            (1.0 - f).reshape(head4), va.astype(f32).reshape(head4), s_hgrn.astype(f32))
    oa = _rmsnorm(oa, g_a_out.reshape(A_HEADS, A_HEAD_DIM)).reshape(bsz, seq, A_WIDTH).astype(x.dtype)
    pa = (oa * jax.nn.silu(ga)) @ w_a_down

    xp = jnp.concatenate([conv_ctx.astype(xb.dtype), xb], axis=1)
    xc = b_conv + sum(w_conv[j] * xp[:, j:j + seq] for j in range(CONV_W))
    conv_new = xp[:, seq:]
    xcb = xc.astype(f32).reshape(bsz, seq, B_BLOCKS, B_BLOCK_DIM)
    r = jax.nn.sigmoid(jnp.einsum('blnd,nde->blne', xcb, w_lru_r.astype(f32)) + b_lru_r.astype(f32).reshape(B_BLOCKS, B_BLOCK_DIM))
    ig = jax.nn.sigmoid(jnp.einsum('blnd,nde->blne', xcb, w_lru_i.astype(f32)) + b_lru_i.astype(f32).reshape(B_BLOCKS, B_BLOCK_DIM))
    log_a = -LRU_C * r * jax.nn.softplus(-lru_lambda.astype(f32).reshape(B_BLOCKS, B_BLOCK_DIM))
    mult = jnp.sqrt(-jnp.expm1(2.0 * log_a))
    if first_is_start:
        mult = jnp.where(jnp.arange(seq)[None, :, None, None] == 0, 1.0, mult)
    u = (mult * ig * xcb).reshape(bsz, seq, B_WIDTH)
    hb, h_lru_new = _lru_scan(jnp.exp(log_a).reshape(bsz, seq, B_WIDTH), u, h_lru.astype(f32))
    pb = (hb.astype(x.dtype) * jax.nn.silu(gb)) @ w_b_down

    qch = qc.reshape(bsz, seq, C_HEADS, C_HEAD_DIM)
    sc = jnp.einsum('blhd,bmhd->bhlm', qch, mem_k).astype(f32) * (C_HEAD_DIM ** -0.5)
    pr = jax.nn.softmax(sc, axis=-1).astype(x.dtype)
    oc = jnp.einsum('bhlm,bmhd->blhd', pr, mem_v).reshape(bsz, seq, C_WIDTH)
    pc = (oc * jax.nn.silu(gc)) @ w_c_down

    merged = jax.nn.sigmoid(za) * pa + jax.nn.sigmoid(zb) * pb + jax.nn.sigmoid(zc) * pc
    y = x + merged @ w_out
    return y, s_hgrn_new, conv_new, h_lru_new


def setup_inputs(seed: int = 0) -> dict:
    key = jax.random.key(seed)
    ks = jax.random.split(key, 32)
    f32 = jnp.float32

    def nrm(k, shape, s):
        return jax.random.normal(k, shape, f32) * s

    u = jax.random.uniform(ks[19], (DEPTH, B_WIDTH), f32, 0.9, 0.999)
    sg = u ** (1.0 / LRU_C)
    return {
        'x_prompt': nrm(ks[0], (BATCH, SEQ, D_MODEL), 1.0),
        'x_sample': nrm(ks[1], (DEC_BATCH, DEC_SEQ, D_MODEL), 1.0),
        'mem_prompt': nrm(ks[2], (BATCH, N_MEM, D_MODEL), 1.0),
        'cache_mem_k': nrm(ks[3], (DEPTH, DEC_BATCH, N_MEM, C_HEADS, C_HEAD_DIM), 1.0),
        'cache_mem_v': nrm(ks[4], (DEPTH, DEC_BATCH, N_MEM, C_HEADS, C_HEAD_DIM), 1.0),
        'state_hgrn': nrm(ks[5], (DEPTH, DEC_BATCH, A_HEADS, A_HEAD_DIM, A_HEAD_DIM), 0.5),
        'state_conv': nrm(ks[6], (DEPTH, DEC_BATCH, CONV_W - 1, B_WIDTH), 1.0),
        'state_lru': nrm(ks[7], (DEPTH, DEC_BATCH, B_WIDTH), 0.5),
        'g_mix': 1.0 + nrm(ks[8], (DEPTH, D_MODEL), 0.05),
        'w_in': nrm(ks[9], (DEPTH, D_MODEL, IN_COLS), D_MODEL ** -0.5),
        'lb_logits': nrm(ks[10], (DEPTH + 1, A_WIDTH), 0.1),
        'g_a_out': 1.0 + nrm(ks[11], (DEPTH, A_WIDTH), 0.05),
        'w_a_down': nrm(ks[12], (DEPTH, A_WIDTH, D_MODEL), A_WIDTH ** -0.5),
        'w_conv': nrm(ks[13], (DEPTH, CONV_W, B_WIDTH), CONV_W ** -0.5),
        'b_conv': nrm(ks[14], (DEPTH, B_WIDTH), 0.01),
        'w_lru_r': nrm(ks[15], (DEPTH, B_BLOCKS, B_BLOCK_DIM, B_BLOCK_DIM), B_BLOCK_DIM ** -0.5),
        'b_lru_r': nrm(ks[16], (DEPTH, B_WIDTH), 0.01),
        'w_lru_i': nrm(ks[17], (DEPTH, B_BLOCKS, B_BLOCK_DIM, B_BLOCK_DIM), B_BLOCK_DIM ** -0.5),
        'b_lru_i': nrm(ks[18], (DEPTH, B_WIDTH), 0.01),
        'lru_lambda': jnp.log(sg) - jnp.log1p(-sg),
        'w_b_down': nrm(ks[20], (DEPTH, B_WIDTH, D_MODEL), B_WIDTH ** -0.5),
        'g_mem': 1.0 + nrm(ks[21], (DEPTH, D_MODEL), 0.05),
        'w_mem_k': nrm(ks[22], (DEPTH, D_MODEL, C_WIDTH), D_MODEL ** -0.5),
        'w_mem_v': nrm(ks[23], (DEPTH, D_MODEL, C_WIDTH), D_MODEL ** -0.5),
        'w_c_down': nrm(ks[24], (DEPTH, C_WIDTH, D_MODEL), C_WIDTH ** -0.5),
        'w_out': nrm(ks[25], (DEPTH, D_MODEL, D_MODEL), D_MODEL ** -0.5),
        'g_final': 1.0 + nrm(ks[26], (D_MODEL,), 0.05),
    }


def reference(x_prompt, x_sample, mem_prompt, cache_mem_k, cache_mem_v, state_hgrn, state_conv, state_lru,
              g_mix, w_in, lb_logits, g_a_out, w_a_down, w_conv, b_conv, w_lru_r, b_lru_r, w_lru_i, b_lru_i,
              lru_lambda, w_b_down, g_mem, w_mem_k, w_mem_v, w_c_down, w_out, g_final):
    f32 = jnp.float32
    lb_all = jnp.cumsum(jax.nn.softmax(lb_logits.astype(f32), axis=0), axis=0)
    bp = x_prompt.shape[0]
    hp, hs = x_prompt, x_sample
    p_hgrn, p_conv, p_lru, p_mk, p_mv = [], [], [], [], []
    s_hgrn, s_conv, s_lru = [], [], []
    for l in range(DEPTH):
        lw = (g_mix[l], w_in[l], g_a_out[l], w_a_down[l], w_conv[l], b_conv[l], w_lru_r[l], b_lru_r[l],
              w_lru_i[l], b_lru_i[l], lru_lambda[l], w_b_down[l], w_c_down[l], w_out[l])
        mk, mv = _memory_kv(mem_prompt, g_mem[l], w_mem_k[l], w_mem_v[l])
        hp, a1, c1, r1 = _mixer_layer(hp, mk, mv,
                                      jnp.zeros((bp, A_HEADS, A_HEAD_DIM, A_HEAD_DIM), f32),
                                      jnp.zeros((bp, CONV_W - 1, B_WIDTH), x_prompt.dtype),
                                      jnp.zeros((bp, B_WIDTH), f32),
                                      True, lb_all[l], *lw)
        hs, a2, c2, r2 = _mixer_layer(hs, cache_mem_k[l], cache_mem_v[l], state_hgrn[l], state_conv[l], state_lru[l],
                                      False, lb_all[l], *lw)
        p_hgrn.append(a1.astype(x_prompt.dtype))
        p_conv.append(c1.astype(x_prompt.dtype))
        p_lru.append(r1.astype(x_prompt.dtype))
        p_mk.append(mk)
        p_mv.append(mv)
        s_hgrn.append(a2.astype(state_hgrn.dtype))
        s_conv.append(c2.astype(state_conv.dtype))
        s_lru.append(r2.astype(state_lru.dtype))
    y_prompt = _rmsnorm(hp, g_final)
    y_sample = _rmsnorm(hs, g_final)
    return (y_prompt, y_sample, jnp.stack(p_hgrn), jnp.stack(p_conv), jnp.stack(p_lru), jnp.stack(p_mk),
            jnp.stack(p_mv), jnp.stack(s_hgrn), jnp.stack(s_conv), jnp.stack(s_lru))
```

```cpp
#include <hip/hip_runtime.h>
#include <cstdio>
#include <cstdint>

#ifndef MK_N_LAUNCHES
#define MK_N_LAUNCHES 8
#endif

#define DI __device__ __forceinline__
#define LAS __attribute__((address_space(3)))
typedef unsigned short bf16;
typedef short bf16x8 __attribute__((ext_vector_type(8)));
typedef float f32x16 __attribute__((ext_vector_type(16)));
typedef float f32x4 __attribute__((ext_vector_type(4)));
typedef float f32x2 __attribute__((ext_vector_type(2)));
typedef unsigned u32x4 __attribute__((ext_vector_type(4)));
typedef unsigned u32x2 __attribute__((ext_vector_type(2)));
typedef __bf16 bf16x2_t __attribute__((ext_vector_type(2)));

constexpr int DM = 1024, NB = 8, SEQ = 2048, DSEQ = 32, NMEM = 256;
constexpr int MP = NB * SEQ, MS = NB * DSEQ, MT = MP + MS;
constexpr int ZP = 5120;
constexpr int ZC_QA = 0, ZC_FA = 512, ZC_VA = 1024, ZC_GA = 1536, ZC_XB = 2048, ZC_GB = 3072, ZC_QC = 4096, ZC_GC = 4608;
constexpr int ZC_MG = 0;
constexpr float EPS = 1e-6f;
constexpr float QSCALE = 0.08838834764831845f * 1.4426950408889634f;

constexpr size_t O_YP = 0, O_YS = 16777216, O_HP = 17039360, O_CP = 17563648, O_LP = 17588224, O_MK = 17596416, O_MV = 18644992,
                 O_HS = 19693568, O_CS = 20217856, O_LS = 20242432;

constexpr size_t MiB = 1u << 20;
constexpr size_t WS_CTL = 0, CTL_ZERO_BYTES = 64 * 1024;
constexpr size_t WS_WIN = 1 * MiB, WS_WA = 17 * MiB, WS_WB = 18 * MiB, WS_WC = 20 * MiB, WS_WOUT = 21 * MiB, WS_WMEM = 23 * MiB,
                 WS_WLRU = 25 * MiB, WS_TAGG = 26 * MiB, WS_CIN = 28 * MiB, WS_DC = 29 * MiB, WS_ST0 = 30 * MiB, WS_KBP = 31 * MiB,
                 WS_VTP = 33 * MiB, WS_KBS = 35 * MiB, WS_VTS = 37 * MiB, WS_HM = 39 * MiB, WS_H = 43 * MiB, WS_Z = 76 * MiB;
constexpr size_t WS_END = WS_Z + (size_t)MT * ZP * 2;
static_assert(WS_H + (size_t)MT * DM * 2 <= WS_Z && WS_END <= 256 * MiB, "ws map");

constexpr int LDS_BYTES = 147456;
constexpr int MISC_OFF = 131072;

DI float bf2f(unsigned short b) { return __uint_as_float((unsigned)b << 16); }
DI unsigned pk2(float lo, float hi) { f32x2 v = {lo, hi}; bf16x2_t b = __builtin_convertvector(v, bf16x2_t); return __builtin_bit_cast(unsigned, b); }
DI float sigm(float x) { return 1.0f / (1.0f + __expf(-x)); }
DI float silu(float x) { return x * sigm(x); }
DI void unpack8(const u32x4 w, float (&f)[8]) {
    f[0] = __uint_as_float(w.x << 16); f[1] = __uint_as_float(w.x & 0xffff0000u);
    f[2] = __uint_as_float(w.y << 16); f[3] = __uint_as_float(w.y & 0xffff0000u);
    f[4] = __uint_as_float(w.z << 16); f[5] = __uint_as_float(w.z & 0xffff0000u);
    f[6] = __uint_as_float(w.w << 16); f[7] = __uint_as_float(w.w & 0xffff0000u);
}
DI void unpack4(const u32x2 w, float (&f)[4]) {
    f[0] = __uint_as_float(w.x << 16); f[1] = __uint_as_float(w.x & 0xffff0000u);
    f[2] = __uint_as_float(w.y << 16); f[3] = __uint_as_float(w.y & 0xffff0000u);
}
DI int crow(int reg, int h) { return (reg & 3) + 8 * (reg >> 2) + 4 * h; }
#define MFMA32(a, b, c) __builtin_amdgcn_mfma_f32_32x32x16_bf16((a), (b), (c), 0, 0, 0)
DI float wave_sum(float v) {
#pragma unroll
    for (int o = 1; o < 64; o <<= 1) v += __shfl_xor(v, o);
    return v;
}

struct Ctx {
    LAS unsigned char* lds;
    int tid, lane, wave, G, bid;
    const float* in[27];
    float* out;
    unsigned char* ws;
};
#define WSP(T, off) ((T*)(c.ws + (off)))

#define XB_TMO      128
#define XB_XCNT(j)  (256  + 64 * (j))
#define XB_XSUB(j)  (1280 + 64 * (j))
#define XB_XGEN(j)  (2304 + 64 * (j))
#define XB_TOP      3328
#define XB_TOPGEN   3392
#define XCD_BAR_WORDS 3456
#define XB_SPIN_CAP (1u << 18)
DI unsigned xb_ld(unsigned* p)              { return __hip_atomic_load(p, __ATOMIC_RELAXED, __HIP_MEMORY_SCOPE_AGENT); }
DI unsigned xb_add(unsigned* p, unsigned v) { return __hip_atomic_fetch_add(p, v, __ATOMIC_RELAXED, __HIP_MEMORY_SCOPE_AGENT); }
DI unsigned xb_xcc_id() { return (unsigned)__builtin_amdgcn_s_getreg((3 << 11) | 20) & 0xFu; }
#define XB_SPIN(cond, bar) do { unsigned _sp = 0; while (cond) { __builtin_amdgcn_s_sleep(1); \
    if ((++_sp & 255u) == 0u) { if (xb_ld(&(bar)[XB_TMO])) break; if (_sp > XB_SPIN_CAP) { atomicAdd(&(bar)[XB_TMO], 1u); break; } } } } while (0)
struct XcdBarrier { unsigned* bar; unsigned x; volatile LAS unsigned* st; };
DI XcdBarrier xcd_barrier_post(unsigned* bar, volatile LAS unsigned* st) {
    XcdBarrier b; b.bar = bar; b.x = xb_xcc_id(); b.st = st;
    if (threadIdx.x == 0) (void)xb_add(&bar[XB_XCNT(b.x)], 1u);
    return b;
}
DI void xcd_barrier_complete(unsigned* bar, unsigned x, unsigned& nloc, unsigned& nx) {
    const unsigned G = gridDim.x * gridDim.y * gridDim.z;
    unsigned sum, cnt, mine, sp = 0u;
    for (;;) {
        sum = 0u; cnt = 0u; mine = 0u;
#pragma unroll
        for (unsigned j = 0; j < 16; ++j) { const unsigned c = xb_ld(&bar[XB_XCNT(j)]); sum += c; cnt += (c > 0u) ? 1u : 0u; mine = (j == x) ? c : mine; }
        if (sum == G) break;
        __builtin_amdgcn_s_sleep(1);
        if ((++sp & 255u) == 0u) { if (xb_ld(&bar[XB_TMO])) break; if (sp > XB_SPIN_CAP) { atomicAdd(&bar[XB_TMO], 1u); break; } }
    }
    nloc = mine > 0u ? mine : 1u; nx = cnt > 0u ? cnt : 1u;
}
DI void xcd_barrier(const XcdBarrier& b) {
    asm volatile("s_waitcnt vmcnt(0)" ::: "memory");
    __syncthreads();
    if (threadIdx.x == 0) {
        unsigned* bar = b.bar;
        __builtin_amdgcn_s_waitcnt(0);
        unsigned nloc = b.st[0], nx = b.st[1];
        if (nloc == 0u) { xcd_barrier_complete(bar, b.x, nloc, nx); b.st[0] = nloc; b.st[1] = nx; }
        const unsigned old = xb_add(&bar[XB_XSUB(b.x)], 1u);
        const unsigned gen = old / nloc;
        if (old + 1u == (gen + 1u) * nloc) {
            __builtin_amdgcn_fence(__ATOMIC_RELEASE, "agent");
            asm volatile("s_waitcnt vmcnt(0)" ::: "memory");
            const unsigned og = xb_add(&bar[XB_TOP], 1u);
            const unsigned tg = og / nx;
            if (og + 1u == (tg + 1u) * nx) xb_add(&bar[XB_TOPGEN], 1u);
            else XB_SPIN(xb_ld(&bar[XB_TOPGEN]) == tg, bar);
            __builtin_amdgcn_fence(__ATOMIC_ACQUIRE, "agent");
            xb_add(&bar[XB_XGEN(b.x)], 1u);
            asm volatile("s_waitcnt vmcnt(0)" ::: "memory");
        } else {
            XB_SPIN(xb_ld(&bar[XB_XGEN(b.x)]) == gen, bar);
            __builtin_amdgcn_fence(__ATOMIC_ACQUIRE, "agent");
            asm volatile("s_waitcnt vmcnt(0)" ::: "memory");
        }
    }
    __syncthreads();
}

DI void p0_transpose_item(const float* W, int K, int N, bf16* WT, int ldt, int row_off, LAS float* scr, int item, int lane) {
    const int nblk = N / 32, kb = item / nblk, nb = item % nblk, k0 = 64 * kb, n0 = 32 * nb;
#pragma unroll 8
    for (int i = 0; i < 32; ++i) { const int kk = 2 * i + (lane >> 5); scr[kk * 33 + (lane & 31)] = W[(size_t)(k0 + kk) * N + n0 + (lane & 31)]; }
    asm volatile("s_waitcnt lgkmcnt(0)" ::: "memory");
    const int cc = lane & 7;
#pragma unroll
    for (int j = 0; j < 4; ++j) { const int n = (lane >> 3) + 8 * j; const LAS float* s = scr + (8 * cc) * 33 + n;
        u32x4 o; o.x = pk2(s[0 * 33], s[1 * 33]); o.y = pk2(s[2 * 33], s[3 * 33]); o.z = pk2(s[4 * 33], s[5 * 33]); o.w = pk2(s[6 * 33], s[7 * 33]);
        *(u32x4*)(WT + (size_t)(row_off + n0 + n) * ldt + k0 + 8 * cc) = o; }
    asm volatile("s_waitcnt lgkmcnt(0)" ::: "memory");
}
DI void rms_row_to_bf16(const float* xrow, const float* g, bf16* orow, int lane) {
    const f32x4* xr = (const f32x4*)xrow + lane; const f32x4* gr = (const f32x4*)g + lane;
    f32x4 v[4]; float s = 0.f;
#pragma unroll
    for (int j = 0; j < 4; ++j) { v[j] = xr[64 * j]; s += (v[j].x * v[j].x + v[j].y * v[j].y) + (v[j].z * v[j].z + v[j].w * v[j].w); }
    const float rs = 1.0f / sqrtf(wave_sum(s) * (1.f / DM) + EPS);
    u32x2* o8 = (u32x2*)orow + lane;
#pragma unroll
    for (int j = 0; j < 4; ++j) { const f32x4 gg = gr[64 * j]; u32x2 w; w.x = pk2(v[j].x * rs * gg.x, v[j].y * rs * gg.y); w.y = pk2(v[j].z * rs * gg.z, v[j].w * rs * gg.w); o8[64 * j] = w; }
}
DI void phase_prologue(Ctx& c) {
    LAS float* scr = (LAS float*)(c.lds + c.wave * 16384);
    const int gw = c.bid * 8 + c.wave, NGW = c.G * 8;
    constexpr int I_WIN = 16 * 256, I_WA = 8 * 32, I_WB = 16 * 32, I_WC = 8 * 32, I_WO = 16 * 32, I_MK = 16 * 16, I_MV = 16 * 16, I_LR = 32, I_LI = 32, I_ST = 32 * 8, I_VS = 8 * 64;
    constexpr int NITEMS = I_WIN + I_WA + I_WB + I_WC + I_WO + I_MK + I_MV + I_LR + I_LI + I_ST + I_VS;
    for (int it = gw; it < NITEMS; it += NGW) {
        int r = it;
        if (r < I_WIN) { p0_transpose_item(c.in[9], 1024, 8192, WSP(bf16, WS_WIN), 1024, 0, scr, r, c.lane); continue; } r -= I_WIN;
        if (r < I_WA) { p0_transpose_item(c.in[12], 512, 1024, WSP(bf16, WS_WA), 512, 0, scr, r, c.lane); continue; } r -= I_WA;
        if (r < I_WB) { p0_transpose_item(c.in[20], 1024, 1024, WSP(bf16, WS_WB), 1024, 0, scr, r, c.lane); continue; } r -= I_WB;
        if (r < I_WC) { p0_transpose_item(c.in[24], 512, 1024, WSP(bf16, WS_WC), 512, 0, scr, r, c.lane); continue; } r -= I_WC;
        if (r < I_WO) { p0_transpose_item(c.in[25], 1024, 1024, WSP(bf16, WS_WOUT), 1024, 0, scr, r, c.lane); continue; } r -= I_WO;
        if (r < I_MK) { p0_transpose_item(c.in[22], 1024, 512, WSP(bf16, WS_WMEM), 1024, 0, scr, r, c.lane); continue; } r -= I_MK;
        if (r < I_MV) { p0_transpose_item(c.in[23], 1024, 512, WSP(bf16, WS_WMEM), 1024, 512, scr, r, c.lane); continue; } r -= I_MV;
        if (r < I_LR) { const int n = r >> 1; p0_transpose_item(c.in[15] + n * 4096, 64, 64, WSP(bf16, WS_WLRU) + n * 4096, 64, 0, scr, r & 1, c.lane); continue; } r -= I_LR;
        if (r < I_LI) { const int n = r >> 1; p0_transpose_item(c.in[17] + n * 4096, 64, 64, WSP(bf16, WS_WLRU) + 65536 + n * 4096, 64, 0, scr, r & 1, c.lane); continue; } r -= I_LI;
        if (r < I_ST) { const int bh = r >> 3; p0_transpose_item(c.in[5] + (size_t)bh * 16384, 128, 128, WSP(bf16, WS_ST0) + (size_t)bh * 16384, 128, 0, scr, r & 7, c.lane); continue; } r -= I_ST;
        { const int b = r >> 6; p0_transpose_item(c.in[4] + (size_t)b * 131072, 256, 512, WSP(bf16, WS_VTS) + (size_t)b * 131072, 256, 0, scr, r & 63, c.lane); }
    }
    for (int m = gw; m < MT + NB * NMEM; m += NGW) {
        if (m < MP) rms_row_to_bf16(c.in[0] + (size_t)m * DM, c.in[8], WSP(bf16, WS_H) + (size_t)m * DM, c.lane);
        else if (m < MT) rms_row_to_bf16(c.in[1] + (size_t)(m - MP) * DM, c.in[8], WSP(bf16, WS_H) + (size_t)m * DM, c.lane);
        else rms_row_to_bf16(c.in[2] + (size_t)(m - MT) * DM, c.in[21], WSP(bf16, WS_HM) + (size_t)(m - MT) * DM, c.lane);
    }
    { const size_t n8 = (size_t)NB * NMEM * 512 / 8; const f32x4* src = (const f32x4*)c.in[3]; u32x4* dst = WSP(u32x4, WS_KBS);
      for (size_t i = (size_t)c.bid * 512 + c.tid; i < n8; i += (size_t)c.G * 512) { const f32x4 a = src[2 * i], b = src[2 * i + 1]; u32x4 o; o.x = pk2(a.x, a.y); o.y = pk2(a.z, a.w); o.z = pk2(b.x, b.y); o.w = pk2(b.z, b.w); dst[i] = o; } }
}

DI int swz128(int row, int chunk) { return row * 128 + ((chunk ^ ((row >> 1) & 7)) << 4); }
DI void gemm_kloop(Ctx& c, f32x16 (&acc)[2], const bf16* A, int lda, const bf16* Bt, int ldb, int K, int m0, int n0) {
    const int tid = c.tid, lane = c.lane, w = c.wave, wr = w >> 1, wc = w & 1, r = lane & 31, h = lane >> 5;
    const int srow = tid >> 2, scp = tid & 3;
    const bf16* ga = A + (size_t)(m0 + srow) * lda + scp * 16;
    const bf16* gb = Bt + (size_t)(n0 + srow) * ldb + scp * 16;
    const int wo0 = swz128(srow, 2 * scp), wo1 = swz128(srow, 2 * scp + 1);
    const int nk = K / 64;
    u32x4 ra0, ra1, rb0, rb1;
    ra0 = *(const u32x4*)(ga); ra1 = *(const u32x4*)(ga + 8); rb0 = *(const u32x4*)(gb); rb1 = *(const u32x4*)(gb + 8);
    __syncthreads();
    *(LAS u32x4*)(c.lds + wo0) = ra0; *(LAS u32x4*)(c.lds + wo1) = ra1; *(LAS u32x4*)(c.lds + 16384 + wo0) = rb0; *(LAS u32x4*)(c.lds + 16384 + wo1) = rb1;
    __syncthreads();
    for (int kt = 0; kt < nk; ++kt) {
        const int cur = (kt & 1) * 32768, nxt = 32768 - cur;
        if (kt + 1 < nk) { const bf16* pa = ga + (kt + 1) * 64; const bf16* pb = gb + (kt + 1) * 64;
            ra0 = *(const u32x4*)(pa); ra1 = *(const u32x4*)(pa + 8); rb0 = *(const u32x4*)(pb); rb1 = *(const u32x4*)(pb + 8); }
#pragma unroll
        for (int s = 0; s < 4; ++s) {
            const bf16x8 af = *(const LAS bf16x8*)(c.lds + cur + swz128(32 * wr + r, 2 * s + h));
#pragma unroll
            for (int j = 0; j < 2; ++j) {
                const bf16x8 bfr = *(const LAS bf16x8*)(c.lds + cur + 16384 + swz128(64 * wc + 32 * j + r, 2 * s + h));
                acc[j] = MFMA32(bfr, af, acc[j]);
            }
        }
        if (kt + 1 < nk) { *(LAS u32x4*)(c.lds + nxt + wo0) = ra0; *(LAS u32x4*)(c.lds + nxt + wo1) = ra1; *(LAS u32x4*)(c.lds + nxt + 16384 + wo0) = rb0; *(LAS u32x4*)(c.lds + nxt + 16384 + wo1) = rb1; }
        __syncthreads();
    }
}
template <class Epi> DI void gemm_epi(Ctx& c, const f32x16 (&acc)[2], int m0, int n0, const Epi& E) {
    const int lane = c.lane, w = c.wave, wr = w >> 1, wc = w & 1, r = lane & 31, h = lane >> 5;
    const int m = m0 + 32 * wr + r;
#pragma unroll
    for (int j = 0; j < 2; ++j)
#pragma unroll
        for (int g = 0; g < 4; ++g) { const int n = n0 + 64 * wc + 32 * j + 8 * g + 4 * h; E(m, n, (f32x4){acc[j][4 * g], acc[j][4 * g + 1], acc[j][4 * g + 2], acc[j][4 * g + 3]}); }
}
template <class Epi> DI void gemm_tile(Ctx& c, const bf16* A, int lda, const bf16* Bt, int ldb, int K, int m0, int n0, const Epi& E) {
    f32x16 acc[2];
#pragma unroll
    for (int j = 0; j < 2; ++j)
#pragma unroll
        for (int i = 0; i < 16; ++i) acc[j][i] = 0.f;
    gemm_kloop(c, acc, A, lda, Bt, ldb, K, m0, n0);
    gemm_epi(c, acc, m0, n0, E);
}

struct EpiZ {
    bf16* Z; float* out;
    DI void operator()(int m, int n, f32x4 v) const {
        if (n >= ZC_XB && n < ZC_GB) {
            int b, t3;
            if (m < MP) { b = m >> 11; t3 = (m & 2047) - 2045; } else { b = (m - MP) >> 5; t3 = ((m - MP) & 31) - 29; }
            if (t3 >= 0) { float* o = out + (m < MP ? O_CP : O_CS) + (size_t)(b * 3 + t3) * 1024 + (n - ZC_XB); *(f32x4*)o = v; }
        }
        const bool act = (n < ZC_FA) || (n >= ZC_GA && n < ZC_XB) || (n >= ZC_GB && n < ZC_QC) || (n >= ZC_GC);
        if (act) { v.x = silu(v.x); v.y = silu(v.y); v.z = silu(v.z); v.w = silu(v.w); }
        if (n >= ZC_QC && n < ZC_GC) { v = v * QSCALE; }
        u32x2 o; o.x = pk2(v.x, v.y); o.y = pk2(v.z, v.w);
        *(u32x2*)(Z + (size_t)m * ZP + n) = o;
    }
};
struct EpiMK {
    bf16* KB; float* out;
    DI void operator()(int m, int n, f32x4 v) const {
        *(f32x4*)(out + O_MK + (size_t)m * 512 + n) = v;
        u32x2 o; o.x = pk2(v.x, v.y); o.y = pk2(v.z, v.w); *(u32x2*)(KB + (size_t)m * 512 + n) = o;
    }
};
struct EpiMV {
    bf16* VT; float* out;
    DI void operator()(int nn, int m, f32x4 v) const {
        float* o = out + O_MV + (size_t)m * 512 + nn; o[0] = v.x; o[512] = v.y; o[1024] = v.z; o[1536] = v.w;
        const int b = m >> 8; u32x2 p; p.x = pk2(v.x, v.y); p.y = pk2(v.z, v.w);
        *(u32x2*)(VT + ((size_t)b * 512 + nn) * 256 + (m & 255)) = p;
    }
};
struct EpiMG { bf16* Z; DI void operator()(int m, int n, f32x4 v) const { u32x2 o; o.x = pk2(v.x, v.y); o.y = pk2(v.z, v.w); *(u32x2*)(Z + (size_t)m * ZP + ZC_MG + n) = o; } };
struct EpiY {
    const float* xp; const float* xs; float* out;
    DI void operator()(int m, int n, f32x4 v) const {
        const float* x = (m < MP) ? xp + (size_t)m * DM + n : xs + (size_t)(m - MP) * DM + n;
        const f32x4 xv = *(const f32x4*)x;
        *(f32x4*)(out + (size_t)m * DM + n) = xv + v;
    }
};

DI void phase_g1(Ctx& c) {
    constexpr int T_Z = (MT / 128) * (ZP / 128), T_K = 16 * 4, T_V = 4 * 16;
    for (int it = c.bid; it < T_Z + T_K + T_V; it += c.G) {
        if (it < T_Z) { const int tm = it / (ZP / 128), tn = it % (ZP / 128);
            gemm_tile(c, WSP(bf16, WS_H), DM, WSP(bf16, WS_WIN), DM, DM, tm * 128, tn * 128, EpiZ{WSP(bf16, WS_Z), c.out}); }
        else if (it < T_Z + T_K) { const int i = it - T_Z, tm = i >> 2, tn = i & 3;
            gemm_tile(c, WSP(bf16, WS_HM), DM, WSP(bf16, WS_WMEM), DM, DM, tm * 128, tn * 128, EpiMK{WSP(bf16, WS_KBP), c.out}); }
        else { const int i = it - T_Z - T_K, tm = i >> 4, tn = i & 15;
            gemm_tile(c, WSP(bf16, WS_WMEM) + (size_t)512 * DM, DM, WSP(bf16, WS_HM), DM, DM, tm * 128, tn * 128, EpiMV{WSP(bf16, WS_VTP), c.out}); }
    }
}
DI void phase_g3(Ctx& c) {
    constexpr int NT = (MT / 128) * 8;
    const bf16* Z = WSP(bf16, WS_Z);
    for (int it = c.bid; it < NT; it += c.G) {
        const int m0 = (it >> 3) * 128, n0 = (it & 7) * 128;
        f32x16 M[2], P[2], Gt[2];
#pragma unroll
        for (int j = 0; j < 2; ++j)
#pragma unroll
            for (int i = 0; i < 16; ++i) M[j][i] = 0.f;
#pragma unroll 1
        for (int br = 0; br < 3; ++br) {
#pragma unroll
            for (int j = 0; j < 2; ++j)
#pragma unroll
                for (int i = 0; i < 16; ++i) P[j][i] = 0.f;
            gemm_kloop(c, P, WSP(bf16, WS_H), DM, WSP(bf16, WS_WIN) + (size_t)(5120 + 1024 * br) * DM, DM, DM, m0, n0);
#pragma unroll
            for (int j = 0; j < 2; ++j)
#pragma unroll
                for (int i = 0; i < 16; ++i) { Gt[j][i] = sigm(P[j][i]); P[j][i] = 0.f; }
            const bf16* Y = Z + (br == 0 ? ZC_GA : br == 1 ? ZC_GB : ZC_GC);
            const bf16* W = br == 0 ? WSP(bf16, WS_WA) : br == 1 ? WSP(bf16, WS_WB) : WSP(bf16, WS_WC);
            const int Kb = br == 1 ? 1024 : 512;
            gemm_kloop(c, P, Y, ZP, W, Kb, Kb, m0, n0);
#pragma unroll
            for (int j = 0; j < 2; ++j)
#pragma unroll
                for (int i = 0; i < 16; ++i) M[j][i] += Gt[j][i] * P[j][i];
        }
        gemm_epi(c, M, m0, n0, EpiMG{WSP(bf16, WS_Z)});
    }
}
DI void phase_g4(Ctx& c) {
    constexpr int NT = (MT / 128) * 8;
    for (int it = c.bid; it < NT; it += c.G) {
        const int m0 = (it >> 3) * 128, n0 = (it & 7) * 128;
        gemm_tile(c, WSP(bf16, WS_Z) + ZC_MG, ZP, WSP(bf16, WS_WOUT), DM, DM, m0, n0, EpiY{c.in[0], c.in[1], c.out});
    }
}
DI void phase_final(Ctx& c) {
    const int gw = c.bid * 8 + c.wave, NGW = c.G * 8;
    for (int m = gw; m < MT; m += NGW) {
        f32x4* xr = (f32x4*)(c.out + (size_t)m * DM) + c.lane; const f32x4* gr = (const f32x4*)c.in[26] + c.lane;
        f32x4 v[4]; float s = 0.f;
#pragma unroll
        for (int j = 0; j < 4; ++j) { v[j] = xr[64 * j]; s += (v[j].x * v[j].x + v[j].y * v[j].y) + (v[j].z * v[j].z + v[j].w * v[j].w); }
        const float rs = 1.0f / sqrtf(wave_sum(s) * (1.f / DM) + EPS);
#pragma unroll
        for (int j = 0; j < 4; ++j) { const f32x4 gg = gr[64 * j]; xr[64 * j] = v[j] * rs * gg; }
    }
}

constexpr int A_BL = 0, A_SEG = 32768, A_BLAST = 34816, A_SS = 35328, A_QG = 36864, A_KG = 53248, A_ATT = 69632, A_VT = 77824, A_KPT = 94208;
DI int swz256(int row, int chunk) { return row * 256 + ((chunk ^ (row & 15)) << 4); }
template <int MODE>
DI void hgrn_item(Ctx& c, int mrow0, int valid, int h, const bf16* STin, bf16* STout, float* DCout, const float* s0, float* snew) {
    const int tid = c.tid, lane = c.lane, w = c.wave, r = lane & 31, hh = lane >> 5;
    bf16* Z = WSP(bf16, WS_Z);
    LAS unsigned char* L = c.lds;
    LAS float* BL = (LAS float*)(L + A_BL); LAS float* SEG = (LAS float*)(L + A_SEG); LAS float* BLAST = (LAS float*)(L + A_BLAST); LAS float* SS = (LAS float*)(L + A_SS);
    const float* lbl = c.in[10];
    const int t = tid >> 3, k16 = (tid & 7) * 16;
    const bool tv = t < valid;
    float omf[16];
    {
        float fa[16], vv[16];
        if (tv) { const bf16* zr = Z + (size_t)(mrow0 + t) * ZP + h * 128 + k16;
            const u32x4 a0 = *(const u32x4*)(zr + ZC_FA), a1 = *(const u32x4*)(zr + ZC_FA + 8), v0 = *(const u32x4*)(zr + ZC_VA), v1 = *(const u32x4*)(zr + ZC_VA + 8);
            float t0[8], t1[8]; unpack8(a0, t0); unpack8(a1, t1);
#pragma unroll
            for (int i = 0; i < 8; ++i) { fa[i] = t0[i]; fa[8 + i] = t1[i]; }
            unpack8(v0, t0); unpack8(v1, t1);
#pragma unroll
            for (int i = 0; i < 8; ++i) { vv[i] = t0[i]; vv[8 + i] = t1[i]; }
        } else {
#pragma unroll
            for (int i = 0; i < 16; ++i) { fa[i] = 0.f; vv[i] = 0.f; }
        }
#pragma unroll
        for (int i = 0; i < 16; ++i) {
            const int k = h * 128 + k16 + i;
            const float lb = 1.0f / (1.0f + __expf(lbl[512 + k] - lbl[k]));
            const float sg = sigm(fa[i]);
            const float f = lb + (1.0f - lb) * sg;
            omf[i] = tv ? (1.0f - lb) * (1.0f - sg) : 0.f;
            BL[t * 128 + k16 + i] = tv ? __logf(f) : 0.f;
            const int v = k16 + i;
            *(LAS unsigned short*)(L + A_VT + swz128(v, t >> 3) + (t & 7) * 2) = (unsigned short)(pk2(vv[i], 0.f) & 0xffffu);
        }
    }
    __syncthreads();
    {
        const int k = tid & 127, seg = tid >> 7; float run = 0.f;
#pragma unroll
        for (int i = 0; i < 16; ++i) { run += BL[(16 * seg + i) * 128 + k]; BL[(16 * seg + i) * 128 + k] = run; }
        SEG[seg * 128 + k] = run;
        __syncthreads();
        float off = 0.f;
#pragma unroll
        for (int s = 0; s < 3; ++s) if (s < seg) off += SEG[s * 128 + k];
        if (seg > 0) {
#pragma unroll
            for (int i = 0; i < 16; ++i) BL[(16 * seg + i) * 128 + k] += off;
        }
        if (seg == 3) BLAST[k] = off + run;
        __syncthreads();
    }
    {
        float bb[16];
#pragma unroll
        for (int i = 0; i < 16; ++i) bb[i] = BL[t * 128 + k16 + i];
        if (MODE & 2) {
            float q[16];
            if (tv) { const bf16* zr = Z + (size_t)(mrow0 + t) * ZP + ZC_QA + h * 128 + k16; const u32x4 q0 = *(const u32x4*)zr, q1 = *(const u32x4*)(zr + 8);
                float t0[8], t1[8]; unpack8(q0, t0); unpack8(q1, t1);
#pragma unroll
                for (int i = 0; i < 8; ++i) { q[i] = t0[i]; q[8 + i] = t1[i]; }
            } else {
#pragma unroll
                for (int i = 0; i < 16; ++i) q[i] = 0.f;
            }
            float qg[16], kg[16];
#pragma unroll
            for (int i = 0; i < 16; ++i) { qg[i] = q[i] * __expf(bb[i]); kg[i] = omf[i] * __expf(-bb[i]); }
#pragma unroll
            for (int cchunk = 0; cchunk < 2; ++cchunk) {
                u32x4 oq, ok; const int o = 8 * cchunk;
                oq.x = pk2(qg[o], qg[o + 1]); oq.y = pk2(qg[o + 2], qg[o + 3]); oq.z = pk2(qg[o + 4], qg[o + 5]); oq.w = pk2(qg[o + 6], qg[o + 7]);
                ok.x = pk2(kg[o], kg[o + 1]); ok.y = pk2(kg[o + 2], kg[o + 3]); ok.z = pk2(kg[o + 4], kg[o + 5]); ok.w = pk2(kg[o + 6], kg[o + 7]);
                *(LAS u32x4*)(L + A_QG + swz256(t, (k16 >> 3) + cchunk)) = oq;
                *(LAS u32x4*)(L + A_KG + swz256(t, (k16 >> 3) + cchunk)) = ok;
            }
        }
        if (MODE & 1) {
#pragma unroll
            for (int i = 0; i < 16; ++i) { const int k = k16 + i; const float kp = omf[i] * __expf(BLAST[k] - bb[i]);
                *(LAS unsigned short*)(L + A_KPT + swz128(k, t >> 3) + (t & 7) * 2) = (unsigned short)(pk2(kp, 0.f) & 0xffffu); }
        }
    }
    __syncthreads();
    if (MODE & 1) {
        const int kt = w & 3, vp = w >> 2;
        f32x16 acc[2];
#pragma unroll
        for (int j = 0; j < 2; ++j)
#pragma unroll
            for (int i = 0; i < 16; ++i) acc[j][i] = 0.f;
#pragma unroll
        for (int s = 0; s < 4; ++s) {
            const bf16x8 a = *(const LAS bf16x8*)(L + A_KPT + swz128(32 * kt + r, 2 * s + hh));
#pragma unroll
            for (int j = 0; j < 2; ++j) { const bf16x8 b = *(const LAS bf16x8*)(L + A_VT + swz128(32 * (2 * vp + j) + r, 2 * s + hh)); acc[j] = MFMA32(a, b, acc[j]); }
        }
        if (MODE == 1) {
#pragma unroll
            for (int j = 0; j < 2; ++j) { const int v = 32 * (2 * vp + j) + r;
#pragma unroll
                for (int g = 0; g < 4; ++g) { const int k = 32 * kt + 8 * g + 4 * hh; u32x2 o; o.x = pk2(acc[j][4 * g], acc[j][4 * g + 1]); o.y = pk2(acc[j][4 * g + 2], acc[j][4 * g + 3]);
                    *(u32x2*)(STout + v * 128 + k) = o; } }
            if (tid < 128) DCout[tid] = __expf(BLAST[tid]);
        } else {
#pragma unroll
            for (int j = 0; j < 2; ++j) { const int v = 32 * (2 * vp + j) + r;
#pragma unroll
                for (int g = 0; g < 4; ++g) {
#pragma unroll
                    for (int i = 4 * g; i < 4 * g + 4; ++i) { const int k = 32 * kt + crow(i, hh); snew[k * 128 + v] = __expf(BLAST[k]) * s0[k * 128 + v] + acc[j][i]; }
                    asm volatile("" ::: "memory"); } }
        }
    }
    if (MODE & 2) {
        if (w < 4) {
            const int si = w >> 1, tj = w & 1;
            f32x16 acc;
#pragma unroll
            for (int i = 0; i < 16; ++i) acc[i] = 0.f;
            if (si <= tj) {
#pragma unroll
                for (int s = 0; s < 8; ++s) { const bf16x8 a = *(const LAS bf16x8*)(L + A_KG + swz256(32 * si + r, 2 * s + hh)); const bf16x8 b = *(const LAS bf16x8*)(L + A_QG + swz256(32 * tj + r, 2 * s + hh)); acc = MFMA32(a, b, acc); }
            }
            const int tt = 32 * tj + r;
#pragma unroll
            for (int g = 0; g < 4; ++g) { const int s0_ = 32 * si + 8 * g + 4 * hh; float v[4];
#pragma unroll
                for (int i = 0; i < 4; ++i) v[i] = (s0_ + i <= tt) ? acc[4 * g + i] : 0.f;
                u32x2 o; o.x = pk2(v[0], v[1]); o.y = pk2(v[2], v[3]);
                *(LAS u32x2*)(L + A_ATT + swz128(tt, s0_ >> 3) + (s0_ & 7) * 2) = o; }
        }
        __syncthreads();
        const int vt = w & 3, tj = w >> 2;
        f32x16 acc;
#pragma unroll
        for (int i = 0; i < 16; ++i) acc[i] = 0.f;
#pragma unroll
        for (int s = 0; s < 4; ++s) { const bf16x8 a = *(const LAS bf16x8*)(L + A_VT + swz128(32 * vt + r, 2 * s + hh)); const bf16x8 b = *(const LAS bf16x8*)(L + A_ATT + swz128(32 * tj + r, 2 * s + hh)); acc = MFMA32(a, b, acc); }
        { const bf16* sp = STin + (32 * vt + r) * 128 + 8 * hh;
#pragma unroll
          for (int s = 0; s < 8; ++s) { const bf16x8 a = *(const bf16x8*)(sp + 16 * s); const bf16x8 b = *(const LAS bf16x8*)(L + A_QG + swz256(32 * tj + r, 2 * s + hh)); acc = MFMA32(a, b, acc); } }
        float ssq = 0.f;
#pragma unroll
        for (int i = 0; i < 16; ++i) ssq += acc[i] * acc[i];
        ssq += __shfl_xor(ssq, 32);
        const int tt = 32 * tj + r;
        if (hh == 0) SS[vt * 64 + tt] = ssq;
        __syncthreads();
        const float tot = (SS[tt] + SS[64 + tt]) + (SS[128 + tt] + SS[192 + tt]);
        const float rs = 1.0f / sqrtf(tot * (1.0f / 128.0f) + EPS);
        if (tt < valid) {
            const float* ga = c.in[11] + h * 128;
#pragma unroll
            for (int g = 0; g < 4; ++g) { const int v0 = 32 * vt + 8 * g + 4 * hh; bf16* zp = Z + (size_t)(mrow0 + tt) * ZP + ZC_GA + h * 128 + v0;
                float gg[4]; unpack4(*(const u32x2*)zp, gg); const f32x4 gw = *(const f32x4*)(ga + v0);
                u32x2 o; o.x = pk2(acc[4 * g] * rs * gw.x * gg[0], acc[4 * g + 1] * rs * gw.y * gg[1]); o.y = pk2(acc[4 * g + 2] * rs * gw.z * gg[2], acc[4 * g + 3] * rs * gw.w * gg[3]);
                *(u32x2*)zp = o; }
        }
    }
    __syncthreads();
}

constexpr int B_XCF = 0, B_XCB = 16384, B_RG = 24576, B_IG = 40960, B_AGG = 57344;
template <int MODE>
DI void lru_item(Ctx& c, int b, int j, int n) {
    const int tid = c.tid, lane = c.lane, w = c.wave, r = lane & 31, hh = lane >> 5;
    bf16* Z = WSP(bf16, WS_Z);
    LAS unsigned char* L = c.lds;
    LAS float* XCF = (LAS float*)(L + B_XCF); LAS float* RG = (LAS float*)(L + B_RG); LAS float* IG = (LAS float*)(L + B_IG); LAS float* AGG = (LAS float*)(L + B_AGG);
    const int valid = (MODE == 2) ? 32 : 64;
    const int rowbase = (MODE == 2) ? MP + b * DSEQ : b * SEQ + 64 * j;
    {
        const int t = tid >> 3, c8 = (tid & 7) * 8, ch = n * 64 + c8;
        float xc[8];
        const f32x4 bc0 = *(const f32x4*)(c.in[14] + ch), bc1 = *(const f32x4*)(c.in[14] + ch + 4);
        xc[0] = bc0.x; xc[1] = bc0.y; xc[2] = bc0.z; xc[3] = bc0.w; xc[4] = bc1.x; xc[5] = bc1.y; xc[6] = bc1.z; xc[7] = bc1.w;
#pragma unroll
        for (int jj = 0; jj < 4; ++jj) {
            float x[8];
            const int T = ((MODE == 2) ? 0 : 64 * j) + t + jj - 3;
            if (T >= 0) { unpack8(*(const u32x4*)(Z + (size_t)(rowbase + t + jj - 3) * ZP + ZC_XB + ch), x); }
            else if (MODE == 2) { const float* sc = c.in[6] + (size_t)(b * 3 + (T + 3)) * 1024 + ch; const f32x4 a0 = *(const f32x4*)sc, a1 = *(const f32x4*)(sc + 4);
                x[0] = a0.x; x[1] = a0.y; x[2] = a0.z; x[3] = a0.w; x[4] = a1.x; x[5] = a1.y; x[6] = a1.z; x[7] = a1.w; }
            else {
#pragma unroll
                for (int i = 0; i < 8; ++i) x[i] = 0.f;
            }
            const f32x4 w0 = *(const f32x4*)(c.in[13] + jj * 1024 + ch), w1 = *(const f32x4*)(c.in[13] + jj * 1024 + ch + 4);
            xc[0] += w0.x * x[0]; xc[1] += w0.y * x[1]; xc[2] += w0.z * x[2]; xc[3] += w0.w * x[3]; xc[4] += w1.x * x[4]; xc[5] += w1.y * x[5]; xc[6] += w1.z * x[6]; xc[7] += w1.w * x[7];
        }
        if (t >= valid) {
#pragma unroll
            for (int i = 0; i < 8; ++i) xc[i] = 0.f;
        }
        *(LAS f32x4*)(XCF + t * 64 + c8) = (f32x4){xc[0], xc[1], xc[2], xc[3]}; *(LAS f32x4*)(XCF + t * 64 + c8 + 4) = (f32x4){xc[4], xc[5], xc[6], xc[7]};
        u32x4 o; o.x = pk2(xc[0], xc[1]); o.y = pk2(xc[2], xc[3]); o.z = pk2(xc[4], xc[5]); o.w = pk2(xc[6], xc[7]);
        *(LAS u32x4*)(L + B_XCB + swz128(t, c8 >> 3)) = o;
    }
    __syncthreads();
    {
        const int gate = w >> 2, tt = (w >> 1) & 1, ee = w & 1;
        const bf16* Wt = WSP(bf16, WS_WLRU) + gate * 65536 + (size_t)n * 4096 + (32 * ee + r) * 64 + 8 * hh;
        f32x16 acc;
#pragma unroll
        for (int i = 0; i < 16; ++i) acc[i] = 0.f;
#pragma unroll
        for (int s = 0; s < 4; ++s) { const bf16x8 a = *(const LAS bf16x8*)(L + B_XCB + swz128(32 * tt + r, 2 * s + hh)); const bf16x8 bq = *(const bf16x8*)(Wt + 16 * s); acc = MFMA32(a, bq, acc); }
        const int e = 32 * ee + r; const float bias = (gate ? c.in[18] : c.in[16])[n * 64 + e];
        LAS float* dst = gate ? IG : RG;
#pragma unroll
        for (int i = 0; i < 16; ++i) dst[(32 * tt + crow(i, hh)) * 64 + e] = sigm(acc[i] + bias);
    }
    __syncthreads();
    {
        const int ch = n * 64 + lane;
        const float sp = log1pf(__expf(-c.in[19][ch]));
        float pc[8], hl[8]; float pr = 1.f, hloc = 0.f;
#pragma unroll
        for (int tk = 0; tk < 8; ++tk) {
            const int t = 8 * w + tk;
            const float rg = RG[t * 64 + lane], ig = IG[t * 64 + lane], xc = XCF[t * 64 + lane];
            const float la = -8.0f * rg * sp;
            const float a = __expf(la);
            float mult = sqrtf(-expm1f(2.0f * la));
            if (MODE != 2 && j == 0 && t == 0) mult = 1.0f;
            const float u = mult * ig * xc;
            hloc = a * hloc + u; pr = pr * a; pc[tk] = pr; hl[tk] = hloc;
        }
        AGG[(w * 64 + lane) * 2] = pr; AGG[(w * 64 + lane) * 2 + 1] = hloc;
        __syncthreads();
        float carry = (MODE == 0) ? 0.f : (MODE == 1) ? WSP(float, WS_CIN)[(size_t)(b * 32 + j) * 1024 + ch] : c.in[7][b * 1024 + ch];
        float ptot = 1.f;
#pragma unroll
        for (int ww = 0; ww < 8; ++ww) if (ww < w) { const float p_ = AGG[(ww * 64 + lane) * 2], h_ = AGG[(ww * 64 + lane) * 2 + 1]; carry = p_ * carry + h_; ptot *= p_; }
        if (MODE == 0) {
            if (w == 7) { float* ta = WSP(float, WS_TAGG) + ((size_t)(b * 32 + j) * 1024 + ch) * 2; ta[0] = ptot * pr; ta[1] = hl[7] + pc[7] * carry; }
        } else {
#pragma unroll
            for (int tk = 0; tk < 8; ++tk) {
                const int t = 8 * w + tk;
                if (t < valid) {
                    const float hv = hl[tk] + pc[tk] * carry;
                    bf16* zp = Z + (size_t)(rowbase + t) * ZP + ZC_GB + ch;
                    const float y = hv * bf2f(*zp);
                    *zp = (unsigned short)(pk2(y, 0.f) & 0xffffu);
                    if (MODE == 2 && t == 31) c.out[O_LS + b * 1024 + ch] = hv;
                }
            }
        }
    }
    __syncthreads();
}

DI void attn_wave_item(Ctx& c, int wi) {
    const int lane = c.lane, r = lane & 31, hh = lane >> 5;
    const int rb = wi >> 2, h = wi & 3, m0 = 32 * rb;
    bf16* Z = WSP(bf16, WS_Z);
    const bf16* KB; const bf16* VT;
    if (rb < MP / 32) { const int b = rb >> 6; KB = WSP(bf16, WS_KBP) + (size_t)b * 256 * 512; VT = WSP(bf16, WS_VTP) + (size_t)b * 512 * 256; }
    else { const int b = rb - MP / 32; KB = WSP(bf16, WS_KBS) + (size_t)b * 256 * 512; VT = WSP(bf16, WS_VTS) + (size_t)b * 512 * 256; }
    bf16x8 qf[8];
    { const bf16* qp = Z + (size_t)(m0 + r) * ZP + ZC_QC + h * 128 + 8 * hh;
#pragma unroll
      for (int s = 0; s < 8; ++s) qf[s] = *(const bf16x8*)(qp + 16 * s); }
    f32x16 O[4];
#pragma unroll
    for (int d = 0; d < 4; ++d)
#pragma unroll
        for (int i = 0; i < 16; ++i) O[d][i] = 0.f;
    float mrun = -INFINITY, l = 0.f;
#pragma unroll 1
    for (int kc = 0; kc < 4; ++kc) {
        f32x16 S[2];
#pragma unroll
        for (int kt = 0; kt < 2; ++kt) {
#pragma unroll
            for (int i = 0; i < 16; ++i) S[kt][i] = 0.f;
            const bf16* kp = KB + (size_t)(64 * kc + 32 * kt + r) * 512 + h * 128 + 8 * hh;
#pragma unroll
            for (int s = 0; s < 8; ++s) { const bf16x8 a = *(const bf16x8*)(kp + 16 * s); S[kt] = MFMA32(a, qf[s], S[kt]); }
        }
        float mx = S[0][0];
#pragma unroll
        for (int i = 0; i < 16; ++i) { mx = fmaxf(mx, S[0][i]); mx = fmaxf(mx, S[1][i]); }
        mx = fmaxf(mx, __shfl_xor(mx, 32));
        const float mnew = fmaxf(mrun, mx);
        const float alpha = exp2f(mrun - mnew);
        mrun = mnew; l *= alpha;
#pragma unroll
        for (int d = 0; d < 4; ++d)
#pragma unroll
            for (int i = 0; i < 16; ++i) O[d][i] *= alpha;
#pragma unroll
        for (int kt = 0; kt < 2; ++kt)
#pragma unroll
            for (int i = 0; i < 16; ++i) { const float p = exp2f(S[kt][i] - mnew); S[kt][i] = p; l += p; }
#pragma unroll
        for (int kt = 0; kt < 2; ++kt)
#pragma unroll
            for (int s2 = 0; s2 < 2; ++s2) {
                u32x4 pw; pw.x = pk2(S[kt][8 * s2], S[kt][8 * s2 + 1]); pw.y = pk2(S[kt][8 * s2 + 2], S[kt][8 * s2 + 3]); pw.z = pk2(S[kt][8 * s2 + 4], S[kt][8 * s2 + 5]); pw.w = pk2(S[kt][8 * s2 + 6], S[kt][8 * s2 + 7]);
                const bf16x8 pb = __builtin_bit_cast(bf16x8, pw);
                const int key0 = 64 * kc + 32 * kt + 16 * s2 + 4 * hh;
#pragma unroll
                for (int d = 0; d < 4; ++d) { const bf16* vp = VT + (size_t)(h * 128 + 32 * d + r) * 256 + key0; const u32x2 lo = *(const u32x2*)vp, hi = *(const u32x2*)(vp + 8);
                    u32x4 av; av.x = lo.x; av.y = lo.y; av.z = hi.x; av.w = hi.y; O[d] = MFMA32(__builtin_bit_cast(bf16x8, av), pb, O[d]); }
            }
    }
    l += __shfl_xor(l, 32);
    const float inv = 1.0f / l;
#pragma unroll
    for (int d = 0; d < 4; ++d)
#pragma unroll
        for (int g = 0; g < 4; ++g) { const int d0 = 32 * d + 8 * g + 4 * hh; bf16* zp = Z + (size_t)(m0 + r) * ZP + ZC_GC + h * 128 + d0;
            float gg[4]; unpack4(*(const u32x2*)zp, gg);
            u32x2 o; o.x = pk2(O[d][4 * g] * inv * gg[0], O[d][4 * g + 1] * inv * gg[1]); o.y = pk2(O[d][4 * g + 2] * inv * gg[2], O[d][4 * g + 3] * inv * gg[3]);
            *(u32x2*)zp = o; }
}

constexpr int N_A_P = 1024, N_B_P = 4096, N_C = 260, N_A_S = 32, N_B_S = 128;
DI void phase_p2a(Ctx& c) {
    bf16* ST = (bf16*)c.out;
    for (int it = c.bid; it < N_A_P + N_B_P + N_C; it += c.G) {
        if (it < N_A_P) { const int b = it >> 7, cc = (it >> 2) & 31, h = it & 3;
            hgrn_item<1>(c, b * SEQ + 64 * cc, 64, h, nullptr, ST + (size_t)it * 16384, WSP(float, WS_DC) + it * 128, nullptr, nullptr); }
        else if (it < N_A_P + N_B_P) { const int i = it - N_A_P, b = i >> 9, j = (i >> 4) & 31, n = i & 15; lru_item<0>(c, b, j, n); }
        else { const int i = it - N_A_P - N_B_P; attn_wave_item(c, i * 8 + c.wave); }
    }
}
DI void phase_p2b(Ctx& c) {
    bf16* ST = (bf16*)c.out;
    for (int e = c.bid * 512 + c.tid; e < 65536 + 8192; e += c.G * 512) {
        if (e < 65536) {
            const int v = e & 127, kg = (e >> 7) & 15, bh = e >> 11, b = bh >> 2, h = bh & 3;
            float s[8];
#pragma unroll
            for (int i = 0; i < 8; ++i) s[i] = 0.f;
            for (int cc = 0; cc < 32; ++cc) {
                const int item = (b * 32 + cc) * 4 + h;
                u32x4* p = (u32x4*)(ST + (size_t)item * 16384 + v * 128 + kg * 8);
                float kv[8]; unpack8(*p, kv);
                u32x4 o; o.x = pk2(s[0], s[1]); o.y = pk2(s[2], s[3]); o.z = pk2(s[4], s[5]); o.w = pk2(s[6], s[7]); *p = o;
                const float* dc = WSP(float, WS_DC) + item * 128 + kg * 8;
#pragma unroll
                for (int i = 0; i < 8; ++i) s[i] = dc[i] * s[i] + kv[i];
            }
#pragma unroll
            for (int i = 0; i < 8; ++i) c.out[O_HP + ((size_t)bh * 128 + kg * 8 + i) * 128 + v] = s[i];
        } else {
            const int e2 = e - 65536, b = e2 >> 10, ch = e2 & 1023; float carry = 0.f;
            for (int j = 0; j < 32; ++j) { const size_t ix = (size_t)(b * 32 + j) * 1024 + ch; WSP(float, WS_CIN)[ix] = carry; const float* ta = WSP(float, WS_TAGG) + ix * 2; carry = ta[0] * carry + ta[1]; }
            c.out[O_LP + b * 1024 + ch] = carry;
        }
    }
}
DI void phase_p2c(Ctx& c) {
    bf16* ST = (bf16*)c.out;
    for (int it = c.bid; it < N_A_P + N_A_S + N_B_P + N_B_S; it += c.G) {
        if (it < N_A_P) { const int b = it >> 7, cc = (it >> 2) & 31, h = it & 3;
            hgrn_item<2>(c, b * SEQ + 64 * cc, 64, h, ST + (size_t)it * 16384, nullptr, nullptr, nullptr, nullptr); }
        else if (it < N_A_P + N_A_S) { const int i = it - N_A_P, b = i >> 2, h = i & 3;
            hgrn_item<3>(c, MP + b * DSEQ, 32, h, WSP(bf16, WS_ST0) + (size_t)i * 16384, nullptr, nullptr, c.in[5] + (size_t)i * 16384, c.out + O_HS + (size_t)i * 16384); }
        else if (it < N_A_P + N_A_S + N_B_P) { const int i = it - N_A_P - N_A_S, b = i >> 9, j = (i >> 4) & 31, n = i & 15; lru_item<1>(c, b, j, n); }
        else { const int i = it - N_A_P - N_A_S - N_B_P, b = i >> 4, n = i & 15; lru_item<2>(c, b, 0, n); }
    }
}

struct Args { const float* in[27]; float* out; unsigned char* ws; int ph_lo, ph_hi; };
constexpr int N_PHASES = 8;
__global__ void __launch_bounds__(512, 2) mk_fwd(Args a) {
    extern __shared__ __attribute__((aligned(16))) unsigned char lds_raw[];
    Ctx c;
    c.lds = (LAS unsigned char*)lds_raw;
    c.tid = threadIdx.x; c.lane = c.tid & 63; c.wave = __builtin_amdgcn_readfirstlane(c.tid >> 6);
    c.G = gridDim.x; c.bid = blockIdx.x;
#pragma unroll
    for (int i = 0; i < 27; ++i) c.in[i] = a.in[i];
    c.out = a.out; c.ws = a.ws;
    volatile LAS unsigned* MISC = (volatile LAS unsigned*)(c.lds + MISC_OFF);
    if (c.tid < 64) MISC[c.tid] = 0u;
    __syncthreads();
    XcdBarrier bar; bar.bar = (unsigned*)(a.ws + WS_CTL) + 1024; bar.x = 0; bar.st = nullptr;
    if (MK_N_LAUNCHES == 1) bar = xcd_barrier_post((unsigned*)(a.ws + WS_CTL) + 1024, MISC + 8);
    const int lo = a.ph_lo, hi = a.ph_hi;
#define IN(k) (lo <= (k) && (k) < hi)
#define SEAM(k) do { if (IN(k) && IN((k) + 1)) xcd_barrier(bar); } while (0)
    if (IN(0)) phase_prologue(c);
    SEAM(0);
    if (IN(1)) phase_g1(c);
    SEAM(1);
    if (IN(2)) phase_p2a(c);
    SEAM(2);
    if (IN(3)) phase_p2b(c);
    SEAM(3);
    if (IN(4)) phase_p2c(c);
    SEAM(4);
    if (IN(5)) phase_g3(c);
    SEAM(5);
    if (IN(6)) phase_g4(c);
    SEAM(6);
    if (IN(7)) phase_final(c);
#undef IN
#undef SEAM
}

extern "C" void kernel_launch(void* const* d_in, const int* in_sizes, int n_in, void* d_out, int out_size, void* d_ws, size_t ws_size, hipStream_t stream) {
    static int grid = 0;
    if (grid == 0) {
        if (n_in != 27 || ws_size < WS_END) { fprintf(stderr, "kernel_launch: unexpected n_in %d / ws_size %zu (need %zu)\n", n_in, ws_size, (size_t)WS_END); grid = -1; return; }
        int dev = 0, cus = 0, per_cu = 0;
        if (hipGetDevice(&dev) != hipSuccess || hipDeviceGetAttribute(&cus, hipDeviceAttributeMultiprocessorCount, dev) != hipSuccess) { grid = -1; return; }
        if (hipFuncSetAttribute((const void*)mk_fwd, hipFuncAttributeMaxDynamicSharedMemorySize, LDS_BYTES) != hipSuccess) { fprintf(stderr, "kernel_launch: hipFuncSetAttribute failed\n"); grid = -1; return; }
        if (hipOccupancyMaxActiveBlocksPerMultiprocessor(&per_cu, (const void*)mk_fwd, 512, LDS_BYTES) != hipSuccess || per_cu < 1) { fprintf(stderr, "kernel_launch: occupancy query says %d\n", per_cu); per_cu = 1; }
        (void)hipGetLastError();
        grid = cus;
    }
    if (grid < 0) return;
    (void)hipMemsetAsync((char*)d_ws + WS_CTL, 0, CTL_ZERO_BYTES, stream);
    Args a{};
    for (int i = 0; i < 27; ++i) a.in[i] = (const float*)d_in[i];
    a.out = (float*)d_out; a.ws = (unsigned char*)d_ws;
    if (MK_N_LAUNCHES == 1) {
        a.ph_lo = 0; a.ph_hi = N_PHASES;
        hipLaunchKernelGGL(mk_fwd, dim3(grid), dim3(512), LDS_BYTES, stream, a);
    } else {
        for (int p = 0; p < N_PHASES; ++p) { a.ph_lo = p; a.ph_hi = p + 1; hipLaunchKernelGGL(mk_fwd, dim3(grid), dim3(512), LDS_BYTES, stream, a); }
    }
}
```

```cpp
#include <hip/hip_runtime.h>
#include <cstdio>
#include <cstdint>

#ifndef MK_N_LAUNCHES
#define MK_N_LAUNCHES 1
#endif

#define DI __device__ __forceinline__
#define LAS __attribute__((address_space(3)))
typedef unsigned short bf16;
typedef short bf16x8 __attribute__((ext_vector_type(8)));
typedef float f32x16 __attribute__((ext_vector_type(16)));
typedef float f32x4 __attribute__((ext_vector_type(4)));
typedef float f32x2 __attribute__((ext_vector_type(2)));
typedef unsigned u32x4 __attribute__((ext_vector_type(4)));
typedef unsigned u32x2 __attribute__((ext_vector_type(2)));
typedef __bf16 bf16x2_t __attribute__((ext_vector_type(2)));

constexpr int DM = 1024, NB = 8, SEQ = 2048, DSEQ = 32, NMEM = 256;
constexpr int MP = NB * SEQ, MS = NB * DSEQ, MT = MP + MS;
constexpr int ZP = 5120;
constexpr int ZC_QA = 0, ZC_FA = 512, ZC_VA = 1024, ZC_GA = 1536, ZC_XB = 2048, ZC_GB = 3072, ZC_QC = 4096, ZC_GC = 4608;
constexpr int ZC_MG = 0;
constexpr float EPS = 1e-6f;
constexpr float QSCALE = 0.08838834764831845f * 1.4426950408889634f;

constexpr size_t O_YP = 0, O_YS = 16777216, O_HP = 17039360, O_CP = 17563648, O_LP = 17588224, O_MK = 17596416, O_MV = 18644992,
                 O_HS = 19693568, O_CS = 20217856, O_LS = 20242432;

constexpr size_t MiB = 1u << 20;
constexpr size_t WS_CTL = 0, CTL_ZERO_BYTES = 64 * 1024;
constexpr size_t WS_WIN = 1 * MiB, WS_WA = 17 * MiB, WS_WB = 18 * MiB, WS_WC = 20 * MiB, WS_WOUT = 21 * MiB, WS_WMEM = 23 * MiB,
                 WS_WLRU = 25 * MiB, WS_TAGG = 26 * MiB, WS_CIN = 28 * MiB, WS_DC = 29 * MiB, WS_ST0 = 30 * MiB, WS_KBP = 31 * MiB,
                 WS_VTP = 33 * MiB, WS_KBS = 35 * MiB, WS_VTS = 37 * MiB, WS_HM = 39 * MiB, WS_H = 43 * MiB, WS_Z = 76 * MiB;
constexpr size_t WS_END = WS_Z + (size_t)MT * ZP * 2;
static_assert(WS_H + (size_t)MT * DM * 2 <= WS_Z && WS_END <= 256 * MiB, "ws map");

constexpr int LDS_BYTES = 147456;
constexpr int MISC_OFF = 131072;

DI float bf2f(unsigned short b) { return __uint_as_float((unsigned)b << 16); }
DI unsigned pk2(float lo, float hi) { f32x2 v = {lo, hi}; bf16x2_t b = __builtin_convertvector(v, bf16x2_t); return __builtin_bit_cast(unsigned, b); }
DI float sigm(float x) { return 1.0f / (1.0f + __expf(-x)); }
DI float silu(float x) { return x * sigm(x); }
DI void unpack8(const u32x4 w, float (&f)[8]) {
    f[0] = __uint_as_float(w.x << 16); f[1] = __uint_as_float(w.x & 0xffff0000u);
    f[2] = __uint_as_float(w.y << 16); f[3] = __uint_as_float(w.y & 0xffff0000u);
    f[4] = __uint_as_float(w.z << 16); f[5] = __uint_as_float(w.z & 0xffff0000u);
    f[6] = __uint_as_float(w.w << 16); f[7] = __uint_as_float(w.w & 0xffff0000u);
}
DI void unpack4(const u32x2 w, float (&f)[4]) {
    f[0] = __uint_as_float(w.x << 16); f[1] = __uint_as_float(w.x & 0xffff0000u);
    f[2] = __uint_as_float(w.y << 16); f[3] = __uint_as_float(w.y & 0xffff0000u);
}
DI int crow(int reg, int h) { return (reg & 3) + 8 * (reg >> 2) + 4 * h; }
#define MFMA32(a, b, c) __builtin_amdgcn_mfma_f32_32x32x16_bf16((a), (b), (c), 0, 0, 0)
DI float wave_sum(float v) {
#pragma unroll
    for (int o = 1; o < 64; o <<= 1) v += __shfl_xor(v, o);
    return v;
}

struct Ctx {
    LAS unsigned char* lds;
    int tid, lane, wave, G, bid;
    const float* in[27];
    float* out;
    unsigned char* ws;
};
#define WSP(T, off) ((T*)(c.ws + (off)))

#define XB_TMO      128
#define XB_XCNT(j)  (256  + 64 * (j))
#define XB_XSUB(j)  (1280 + 64 * (j))
#define XB_XGEN(j)  (2304 + 64 * (j))
#define XB_TOP      3328
#define XB_TOPGEN   3392
#define XCD_BAR_WORDS 3456
#define XB_SPIN_CAP (1u << 18)
DI unsigned xb_ld(unsigned* p)              { return __hip_atomic_load(p, __ATOMIC_RELAXED, __HIP_MEMORY_SCOPE_AGENT); }
DI unsigned xb_add(unsigned* p, unsigned v) { return __hip_atomic_fetch_add(p, v, __ATOMIC_RELAXED, __HIP_MEMORY_SCOPE_AGENT); }
DI unsigned xb_xcc_id() { return (unsigned)__builtin_amdgcn_s_getreg((3 << 11) | 20) & 0xFu; }
#define XB_SPIN(cond, bar) do { unsigned _sp = 0; while (cond) { __builtin_amdgcn_s_sleep(1); \
    if ((++_sp & 255u) == 0u) { if (xb_ld(&(bar)[XB_TMO])) break; if (_sp > XB_SPIN_CAP) { atomicAdd(&(bar)[XB_TMO], 1u); break; } } } } while (0)
struct XcdBarrier { unsigned* bar; unsigned x; volatile LAS unsigned* st; };
DI XcdBarrier xcd_barrier_post(unsigned* bar, volatile LAS unsigned* st) {
    XcdBarrier b; b.bar = bar; b.x = xb_xcc_id(); b.st = st;
    if (threadIdx.x == 0) (void)xb_add(&bar[XB_XCNT(b.x)], 1u);
    return b;
}
DI void xcd_barrier_complete(unsigned* bar, unsigned x, unsigned& nloc, unsigned& nx) {
    const unsigned G = gridDim.x * gridDim.y * gridDim.z;
    unsigned sum, cnt, mine, sp = 0u;
    for (;;) {
        sum = 0u; cnt = 0u; mine = 0u;
#pragma unroll
        for (unsigned j = 0; j < 16; ++j) { const unsigned c = xb_ld(&bar[XB_XCNT(j)]); sum += c; cnt += (c > 0u) ? 1u : 0u; mine = (j == x) ? c : mine; }
        if (sum == G) break;
        __builtin_amdgcn_s_sleep(1);
        if ((++sp & 255u) == 0u) { if (xb_ld(&bar[XB_TMO])) break; if (sp > XB_SPIN_CAP) { atomicAdd(&bar[XB_TMO], 1u); break; } }
    }
    nloc = mine > 0u ? mine : 1u; nx = cnt > 0u ? cnt : 1u;
}
DI void xcd_barrier(const XcdBarrier& b) {
    asm volatile("s_waitcnt vmcnt(0)" ::: "memory");
    __syncthreads();
    if (threadIdx.x == 0) {
        unsigned* bar = b.bar;
        __builtin_amdgcn_s_waitcnt(0);
        unsigned nloc = b.st[0], nx = b.st[1];
        if (nloc == 0u) { xcd_barrier_complete(bar, b.x, nloc, nx); b.st[0] = nloc; b.st[1] = nx; }
        const unsigned old = xb_add(&bar[XB_XSUB(b.x)], 1u);
        const unsigned gen = old / nloc;
        if (old + 1u == (gen + 1u) * nloc) {
            __builtin_amdgcn_fence(__ATOMIC_RELEASE, "agent");
            asm volatile("s_waitcnt vmcnt(0)" ::: "memory");
            const unsigned og = xb_add(&bar[XB_TOP], 1u);
            const unsigned tg = og / nx;
            if (og + 1u == (tg + 1u) * nx) xb_add(&bar[XB_TOPGEN], 1u);
            else XB_SPIN(xb_ld(&bar[XB_TOPGEN]) == tg, bar);
            __builtin_amdgcn_fence(__ATOMIC_ACQUIRE, "agent");
            xb_add(&bar[XB_XGEN(b.x)], 1u);
            asm volatile("s_waitcnt vmcnt(0)" ::: "memory");
        } else {
            XB_SPIN(xb_ld(&bar[XB_XGEN(b.x)]) == gen, bar);
            __builtin_amdgcn_fence(__ATOMIC_ACQUIRE, "agent");
            asm volatile("s_waitcnt vmcnt(0)" ::: "memory");
        }
    }
    __syncthreads();
}

DI void p0_transpose_item(const float* W, int K, int N, bf16* WT, int ldt, int row_off, LAS float* scr, int item, int lane) {
    const int nblk = N / 32, kb = item / nblk, nb = item % nblk, k0 = 64 * kb, n0 = 32 * nb;
#pragma unroll 8
    for (int i = 0; i < 32; ++i) { const int kk = 2 * i + (lane >> 5); scr[kk * 33 + (lane & 31)] = W[(size_t)(k0 + kk) * N + n0 + (lane & 31)]; }
    asm volatile("s_waitcnt lgkmcnt(0)" ::: "memory");
    const int cc = lane & 7;
#pragma unroll
    for (int j = 0; j < 4; ++j) { const int n = (lane >> 3) + 8 * j; const LAS float* s = scr + (8 * cc) * 33 + n;
        u32x4 o; o.x = pk2(s[0 * 33], s[1 * 33]); o.y = pk2(s[2 * 33], s[3 * 33]); o.z = pk2(s[4 * 33], s[5 * 33]); o.w = pk2(s[6 * 33], s[7 * 33]);
        *(u32x4*)(WT + (size_t)(row_off + n0 + n) * ldt + k0 + 8 * cc) = o; }
    asm volatile("s_waitcnt lgkmcnt(0)" ::: "memory");
}
DI void rms_row_to_bf16(const float* xrow, const float* g, bf16* orow, int lane) {
    const f32x4* xr = (const f32x4*)xrow + lane; const f32x4* gr = (const f32x4*)g + lane;
    f32x4 v[4]; float s = 0.f;
#pragma unroll
    for (int j = 0; j < 4; ++j) { v[j] = xr[64 * j]; s += (v[j].x * v[j].x + v[j].y * v[j].y) + (v[j].z * v[j].z + v[j].w * v[j].w); }
    const float rs = 1.0f / sqrtf(wave_sum(s) * (1.f / DM) + EPS);
    u32x2* o8 = (u32x2*)orow + lane;
#pragma unroll
    for (int j = 0; j < 4; ++j) { const f32x4 gg = gr[64 * j]; u32x2 w; w.x = pk2(v[j].x * rs * gg.x, v[j].y * rs * gg.y); w.y = pk2(v[j].z * rs * gg.z, v[j].w * rs * gg.w); o8[64 * j] = w; }
}
DI void phase_prologue(Ctx& c) {
    LAS float* scr = (LAS float*)(c.lds + c.wave * 16384);
    const int gw = c.bid * 8 + c.wave, NGW = c.G * 8;
    constexpr int I_WIN = 16 * 256, I_WA = 8 * 32, I_WB = 16 * 32, I_WC = 8 * 32, I_WO = 16 * 32, I_MK = 16 * 16, I_MV = 16 * 16, I_LR = 32, I_LI = 32, I_ST = 32 * 8, I_VS = 8 * 64;
    constexpr int NITEMS = I_WIN + I_WA + I_WB + I_WC + I_WO + I_MK + I_MV + I_LR + I_LI + I_ST + I_VS;
    for (int it = gw; it < NITEMS; it += NGW) {
        int r = it;
        if (r < I_WIN) { p0_transpose_item(c.in[9], 1024, 8192, WSP(bf16, WS_WIN), 1024, 0, scr, r, c.lane); continue; } r -= I_WIN;
        if (r < I_WA) { p0_transpose_item(c.in[12], 512, 1024, WSP(bf16, WS_WA), 512, 0, scr, r, c.lane); continue; } r -= I_WA;
        if (r < I_WB) { p0_transpose_item(c.in[20], 1024, 1024, WSP(bf16, WS_WB), 1024, 0, scr, r, c.lane); continue; } r -= I_WB;
        if (r < I_WC) { p0_transpose_item(c.in[24], 512, 1024, WSP(bf16, WS_WC), 512, 0, scr, r, c.lane); continue; } r -= I_WC;
        if (r < I_WO) { p0_transpose_item(c.in[25], 1024, 1024, WSP(bf16, WS_WOUT), 1024, 0, scr, r, c.lane); continue; } r -= I_WO;
        if (r < I_MK) { p0_transpose_item(c.in[22], 1024, 512, WSP(bf16, WS_WMEM), 1024, 0, scr, r, c.lane); continue; } r -= I_MK;
        if (r < I_MV) { p0_transpose_item(c.in[23], 1024, 512, WSP(bf16, WS_WMEM), 1024, 512, scr, r, c.lane); continue; } r -= I_MV;
        if (r < I_LR) { const int n = r >> 1; p0_transpose_item(c.in[15] + n * 4096, 64, 64, WSP(bf16, WS_WLRU) + n * 4096, 64, 0, scr, r & 1, c.lane); continue; } r -= I_LR;
        if (r < I_LI) { const int n = r >> 1; p0_transpose_item(c.in[17] + n * 4096, 64, 64, WSP(bf16, WS_WLRU) + 65536 + n * 4096, 64, 0, scr, r & 1, c.lane); continue; } r -= I_LI;
        if (r < I_ST) { const int bh = r >> 3; p0_transpose_item(c.in[5] + (size_t)bh * 16384, 128, 128, WSP(bf16, WS_ST0) + (size_t)bh * 16384, 128, 0, scr, r & 7, c.lane); continue; } r -= I_ST;
        { const int b = r >> 6; p0_transpose_item(c.in[4] + (size_t)b * 131072, 256, 512, WSP(bf16, WS_VTS) + (size_t)b * 131072, 256, 0, scr, r & 63, c.lane); }
    }
    for (int m = gw; m < MT + NB * NMEM; m += NGW) {
        if (m < MP) rms_row_to_bf16(c.in[0] + (size_t)m * DM, c.in[8], WSP(bf16, WS_H) + (size_t)m * DM, c.lane);
        else if (m < MT) rms_row_to_bf16(c.in[1] + (size_t)(m - MP) * DM, c.in[8], WSP(bf16, WS_H) + (size_t)m * DM, c.lane);
        else rms_row_to_bf16(c.in[2] + (size_t)(m - MT) * DM, c.in[21], WSP(bf16, WS_HM) + (size_t)(m - MT) * DM, c.lane);
    }
    { const size_t n8 = (size_t)NB * NMEM * 512 / 8; const f32x4* src = (const f32x4*)c.in[3]; u32x4* dst = WSP(u32x4, WS_KBS);
      for (size_t i = (size_t)c.bid * 512 + c.tid; i < n8; i += (size_t)c.G * 512) { const f32x4 a = src[2 * i], b = src[2 * i + 1]; u32x4 o; o.x = pk2(a.x, a.y); o.y = pk2(a.z, a.w); o.z = pk2(b.x, b.y); o.w = pk2(b.z, b.w); dst[i] = o; } }
}

DI int swz128(int row, int chunk) { return row * 128 + ((chunk ^ ((row >> 1) & 7)) << 4); }
DI void gemm_kloop(Ctx& c, f32x16 (&acc)[2], const bf16* A, int lda, const bf16* Bt, int ldb, int K, int m0, int n0) {
    const int tid = c.tid, lane = c.lane, w = c.wave, wr = w >> 1, wc = w & 1, r = lane & 31, h = lane >> 5;
    const int srow = tid >> 2, scp = tid & 3;
    const bf16* ga = A + (size_t)(m0 + srow) * lda + scp * 16;
    const bf16* gb = Bt + (size_t)(n0 + srow) * ldb + scp * 16;
    const int wo0 = swz128(srow, 2 * scp), wo1 = swz128(srow, 2 * scp + 1);
    const int nk = K / 64;
    u32x4 ra0, ra1, rb0, rb1;
    ra0 = *(const u32x4*)(ga); ra1 = *(const u32x4*)(ga + 8); rb0 = *(const u32x4*)(gb); rb1 = *(const u32x4*)(gb + 8);
    __syncthreads();
    *(LAS u32x4*)(c.lds + wo0) = ra0; *(LAS u32x4*)(c.lds + wo1) = ra1; *(LAS u32x4*)(c.lds + 16384 + wo0) = rb0; *(LAS u32x4*)(c.lds + 16384 + wo1) = rb1;
    __syncthreads();
    for (int kt = 0; kt < nk; ++kt) {
        const int cur = (kt & 1) * 32768, nxt = 32768 - cur;
        if (kt + 1 < nk) { const bf16* pa = ga + (kt + 1) * 64; const bf16* pb = gb + (kt + 1) * 64;
            ra0 = *(const u32x4*)(pa); ra1 = *(const u32x4*)(pa + 8); rb0 = *(const u32x4*)(pb); rb1 = *(const u32x4*)(pb + 8); }
#pragma unroll
        for (int s = 0; s < 4; ++s) {
            const bf16x8 af = *(const LAS bf16x8*)(c.lds + cur + swz128(32 * wr + r, 2 * s + h));
#pragma unroll
            for (int j = 0; j < 2; ++j) {
                const bf16x8 bfr = *(const LAS bf16x8*)(c.lds + cur + 16384 + swz128(64 * wc + 32 * j + r, 2 * s + h));
                acc[j] = MFMA32(bfr, af, acc[j]);
            }
        }
        if (kt + 1 < nk) { *(LAS u32x4*)(c.lds + nxt + wo0) = ra0; *(LAS u32x4*)(c.lds + nxt + wo1) = ra1; *(LAS u32x4*)(c.lds + nxt + 16384 + wo0) = rb0; *(LAS u32x4*)(c.lds + nxt + 16384 + wo1) = rb1; }
        __syncthreads();
    }
}
template <class Epi> DI void gemm_epi(Ctx& c, const f32x16 (&acc)[2], int m0, int n0, const Epi& E) {
    const int lane = c.lane, w = c.wave, wr = w >> 1, wc = w & 1, r = lane & 31, h = lane >> 5;
    const int m = m0 + 32 * wr + r;
#pragma unroll
    for (int j = 0; j < 2; ++j)
#pragma unroll
        for (int g = 0; g < 4; ++g) { const int n = n0 + 64 * wc + 32 * j + 8 * g + 4 * h; E(m, n, (f32x4){acc[j][4 * g], acc[j][4 * g + 1], acc[j][4 * g + 2], acc[j][4 * g + 3]}); }
}
template <class Epi> DI void gemm_tile(Ctx& c, const bf16* A, int lda, const bf16* Bt, int ldb, int K, int m0, int n0, const Epi& E) {
    f32x16 acc[2];
#pragma unroll
    for (int j = 0; j < 2; ++j)
#pragma unroll
        for (int i = 0; i < 16; ++i) acc[j][i] = 0.f;
    gemm_kloop(c, acc, A, lda, Bt, ldb, K, m0, n0);
    gemm_epi(c, acc, m0, n0, E);
}

struct EpiZ {
    bf16* Z; float* out;
    DI void operator()(int m, int n, f32x4 v) const {
        if (n >= ZC_XB && n < ZC_GB) {
            int b, t3;
            if (m < MP) { b = m >> 11; t3 = (m & 2047) - 2045; } else { b = (m - MP) >> 5; t3 = ((m - MP) & 31) - 29; }
            if (t3 >= 0) { float* o = out + (m < MP ? O_CP : O_CS) + (size_t)(b * 3 + t3) * 1024 + (n - ZC_XB); *(f32x4*)o = v; }
        }
        const bool act = (n < ZC_FA) || (n >= ZC_GA && n < ZC_XB) || (n >= ZC_GB && n < ZC_QC) || (n >= ZC_GC);
        if (act) { v.x = silu(v.x); v.y = silu(v.y); v.z = silu(v.z); v.w = silu(v.w); }
        if (n >= ZC_QC && n < ZC_GC) { v = v * QSCALE; }
        u32x2 o; o.x = pk2(v.x, v.y); o.y = pk2(v.z, v.w);
        *(u32x2*)(Z + (size_t)m * ZP + n) = o;
    }
};
struct EpiMK {
    bf16* KB; float* out;
    DI void operator()(int m, int n, f32x4 v) const {
        *(f32x4*)(out + O_MK + (size_t)m * 512 + n) = v;
        u32x2 o; o.x = pk2(v.x, v.y); o.y = pk2(v.z, v.w); *(u32x2*)(KB + (size_t)m * 512 + n) = o;
    }
};
struct EpiMV {
    bf16* VT; float* out;
    DI void operator()(int nn, int m, f32x4 v) const {
        float* o = out + O_MV + (size_t)m * 512 + nn; o[0] = v.x; o[512] = v.y; o[1024] = v.z; o[1536] = v.w;
        const int b = m >> 8; u32x2 p; p.x = pk2(v.x, v.y); p.y = pk2(v.z, v.w);
        *(u32x2*)(VT + ((size_t)b * 512 + nn) * 256 + (m & 255)) = p;
    }
};
struct EpiMG { bf16* Z; DI void operator()(int m, int n, f32x4 v) const { u32x2 o; o.x = pk2(v.x, v.y); o.y = pk2(v.z, v.w); *(u32x2*)(Z + (size_t)m * ZP + ZC_MG + n) = o; } };
struct EpiY {
    const float* xp; const float* xs; float* out;
    DI void operator()(int m, int n, f32x4 v) const {
        const float* x = (m < MP) ? xp + (size_t)m * DM + n : xs + (size_t)(m - MP) * DM + n;
        const f32x4 xv = *(const f32x4*)x;
        *(f32x4*)(out + (size_t)m * DM + n) = xv + v;
    }
};

DI void phase_g1(Ctx& c) {
    constexpr int T_Z = (MT / 128) * (ZP / 128), T_K = 16 * 4, T_V = 4 * 16;
    for (int it = c.bid; it < T_Z + T_K + T_V; it += c.G) {
        if (it < T_Z) { const int tm = it / (ZP / 128), tn = it % (ZP / 128);
            gemm_tile(c, WSP(bf16, WS_H), DM, WSP(bf16, WS_WIN), DM, DM, tm * 128, tn * 128, EpiZ{WSP(bf16, WS_Z), c.out}); }
        else if (it < T_Z + T_K) { const int i = it - T_Z, tm = i >> 2, tn = i & 3;
            gemm_tile(c, WSP(bf16, WS_HM), DM, WSP(bf16, WS_WMEM), DM, DM, tm * 128, tn * 128, EpiMK{WSP(bf16, WS_KBP), c.out}); }
        else { const int i = it - T_Z - T_K, tm = i >> 4, tn = i & 15;
            gemm_tile(c, WSP(bf16, WS_WMEM) + (size_t)512 * DM, DM, WSP(bf16, WS_HM), DM, DM, tm * 128, tn * 128, EpiMV{WSP(bf16, WS_VTP), c.out}); }
    }
}
DI void phase_g3(Ctx& c) {
    constexpr int NT = (MT / 128) * 8;
    const bf16* Z = WSP(bf16, WS_Z);
    for (int it = c.bid; it < NT; it += c.G) {
        const int m0 = (it >> 3) * 128, n0 = (it & 7) * 128;
        f32x16 M[2], P[2], Gt[2];
#pragma unroll
        for (int j = 0; j < 2; ++j)
#pragma unroll
            for (int i = 0; i < 16; ++i) M[j][i] = 0.f;
#pragma unroll 1
        for (int br = 0; br < 3; ++br) {
#pragma unroll
            for (int j = 0; j < 2; ++j)
#pragma unroll
                for (int i = 0; i < 16; ++i) P[j][i] = 0.f;
            gemm_kloop(c, P, WSP(bf16, WS_H), DM, WSP(bf16, WS_WIN) + (size_t)(5120 + 1024 * br) * DM, DM, DM, m0, n0);
#pragma unroll
            for (int j = 0; j < 2; ++j)
#pragma unroll
                for (int i = 0; i < 16; ++i) { Gt[j][i] = sigm(P[j][i]); P[j][i] = 0.f; }
            const bf16* Y = Z + (br == 0 ? ZC_GA : br == 1 ? ZC_GB : ZC_GC);
            const bf16* W = br == 0 ? WSP(bf16, WS_WA) : br == 1 ? WSP(bf16, WS_WB) : WSP(bf16, WS_WC);
            const int Kb = br == 1 ? 1024 : 512;
            gemm_kloop(c, P, Y, ZP, W, Kb, Kb, m0, n0);
#pragma unroll
            for (int j = 0; j < 2; ++j)
#pragma unroll
                for (int i = 0; i < 16; ++i) M[j][i] += Gt[j][i] * P[j][i];
        }
        gemm_epi(c, M, m0, n0, EpiMG{WSP(bf16, WS_Z)});
    }
}
DI void phase_g4(Ctx& c) {
    constexpr int NT = (MT / 128) * 8;
    for (int it = c.bid; it < NT; it += c.G) {
        const int m0 = (it >> 3) * 128, n0 = (it & 7) * 128;
        gemm_tile(c, WSP(bf16, WS_Z) + ZC_MG, ZP, WSP(bf16, WS_WOUT), DM, DM, m0, n0, EpiY{c.in[0], c.in[1], c.out});
    }
}
DI void phase_final(Ctx& c) {
    const int gw = c.bid * 8 + c.wave, NGW = c.G * 8;
    for (int m = gw; m < MT; m += NGW) {
        f32x4* xr = (f32x4*)(c.out + (size_t)m * DM) + c.lane; const f32x4* gr = (const f32x4*)c.in[26] + c.lane;
        f32x4 v[4]; float s = 0.f;
#pragma unroll
        for (int j = 0; j < 4; ++j) { v[j] = xr[64 * j]; s += (v[j].x * v[j].x + v[j].y * v[j].y) + (v[j].z * v[j].z + v[j].w * v[j].w); }
        const float rs = 1.0f / sqrtf(wave_sum(s) * (1.f / DM) + EPS);
#pragma unroll
        for (int j = 0; j < 4; ++j) { const f32x4 gg = gr[64 * j]; xr[64 * j] = v[j] * rs * gg; }
    }
}

constexpr int A_BL = 0, A_SEG = 32768, A_BLAST = 34816, A_SS = 35328, A_QG = 36864, A_KG = 53248, A_ATT = 69632, A_VT = 77824, A_KPT = 94208;
DI int swz256(int row, int chunk) { return row * 256 + ((chunk ^ (row & 15)) << 4); }
template <int MODE>
DI void hgrn_item(Ctx& c, int mrow0, int valid, int h, const bf16* STin, bf16* STout, float* DCout, const float* s0, float* snew) {
    const int tid = c.tid, lane = c.lane, w = c.wave, r = lane & 31, hh = lane >> 5;
    bf16* Z = WSP(bf16, WS_Z);
    LAS unsigned char* L = c.lds;
    LAS float* BL = (LAS float*)(L + A_BL); LAS float* SEG = (LAS float*)(L + A_SEG); LAS float* BLAST = (LAS float*)(L + A_BLAST); LAS float* SS = (LAS float*)(L + A_SS);
    const float* lbl = c.in[10];
    const int t = tid >> 3, k16 = (tid & 7) * 16;
    const bool tv = t < valid;
#pragma unroll 1
    for (int half = 0; half < 2; ++half) {
        const int k8 = k16 + 8 * half;
        float fa[8], vv[8];
        if (tv) { const bf16* zr = Z + (size_t)(mrow0 + t) * ZP + h * 128 + k8;
            unpack8(*(const u32x4*)(zr + ZC_FA), fa); unpack8(*(const u32x4*)(zr + ZC_VA), vv);
        } else {
#pragma unroll
            for (int i = 0; i < 8; ++i) { fa[i] = 0.f; vv[i] = 0.f; }
        }
#pragma unroll
        for (int i = 0; i < 8; ++i) {
            const int k = h * 128 + k8 + i;
            const float lb = 1.0f / (1.0f + __expf(lbl[512 + k] - lbl[k]));
            const float f = lb + (1.0f - lb) * sigm(fa[i]);
            BL[t * 128 + k8 + i] = tv ? __logf(f) : 0.f;
            const int v = k8 + i;
            *(LAS unsigned short*)(L + A_VT + swz128(v, t >> 3) + (t & 7) * 2) = (unsigned short)(pk2(vv[i], 0.f) & 0xffffu);
        }
    }
    __syncthreads();
    {
        const int k = tid & 127, seg = tid >> 7; float run = 0.f;
#pragma unroll
        for (int i = 0; i < 16; ++i) { run += BL[(16 * seg + i) * 128 + k]; BL[(16 * seg + i) * 128 + k] = run; }
        SEG[seg * 128 + k] = run;
        __syncthreads();
        float off = 0.f;
#pragma unroll
        for (int s = 0; s < 3; ++s) if (s < seg) off += SEG[s * 128 + k];
        if (seg > 0) {
#pragma unroll
            for (int i = 0; i < 16; ++i) BL[(16 * seg + i) * 128 + k] += off;
        }
        if (seg == 3) BLAST[k] = off + run;
        __syncthreads();
    }
#pragma unroll 1
    for (int half = 0; half < 2; ++half) {
        const int k8 = k16 + 8 * half;
        float bb[8], omf[8];
#pragma unroll
        for (int i = 0; i < 8; ++i) bb[i] = BL[t * 128 + k8 + i];
        {
            float fa[8];
            if (tv) unpack8(*(const u32x4*)(Z + (size_t)(mrow0 + t) * ZP + ZC_FA + h * 128 + k8), fa);
            else {
#pragma unroll
                for (int i = 0; i < 8; ++i) fa[i] = 0.f;
            }
#pragma unroll
            for (int i = 0; i < 8; ++i) { const int k = h * 128 + k8 + i; const float lb = 1.0f / (1.0f + __expf(lbl[512 + k] - lbl[k])); omf[i] = tv ? (1.0f - lb) * (1.0f - sigm(fa[i])) : 0.f; }
        }
        if (MODE & 2) {
            float q[8];
            if (tv) unpack8(*(const u32x4*)(Z + (size_t)(mrow0 + t) * ZP + ZC_QA + h * 128 + k8), q);
            else {
#pragma unroll
                for (int i = 0; i < 8; ++i) q[i] = 0.f;
            }
            float qg[8], kg[8];
#pragma unroll
            for (int i = 0; i < 8; ++i) { qg[i] = q[i] * __expf(bb[i]); kg[i] = omf[i] * __expf(-bb[i]); }
            u32x4 oq, ok;
            oq.x = pk2(qg[0], qg[1]); oq.y = pk2(qg[2], qg[3]); oq.z = pk2(qg[4], qg[5]); oq.w = pk2(qg[6], qg[7]);
            ok.x = pk2(kg[0], kg[1]); ok.y = pk2(kg[2], kg[3]); ok.z = pk2(kg[4], kg[5]); ok.w = pk2(kg[6], kg[7]);
            *(LAS u32x4*)(L + A_QG + swz256(t, k8 >> 3)) = oq;
            *(LAS u32x4*)(L + A_KG + swz256(t, k8 >> 3)) = ok;
        }
        if (MODE & 1) {
#pragma unroll
            for (int i = 0; i < 8; ++i) { const int k = k8 + i; const float kp = omf[i] * __expf(BLAST[k] - bb[i]);
                *(LAS unsigned short*)(L + A_KPT + swz128(k, t >> 3) + (t & 7) * 2) = (unsigned short)(pk2(kp, 0.f) & 0xffffu); }
        }
    }
    __syncthreads();
    if (MODE & 1) {
        const int kt = w & 3, vp = w >> 2;
        f32x16 acc[2];
#pragma unroll
        for (int j = 0; j < 2; ++j)
#pragma unroll
            for (int i = 0; i < 16; ++i) acc[j][i] = 0.f;
#pragma unroll
        for (int s = 0; s < 4; ++s) {
            const bf16x8 a = *(const LAS bf16x8*)(L + A_KPT + swz128(32 * kt + r, 2 * s + hh));
#pragma unroll
            for (int j = 0; j < 2; ++j) { const bf16x8 b = *(const LAS bf16x8*)(L + A_VT + swz128(32 * (2 * vp + j) + r, 2 * s + hh)); acc[j] = MFMA32(a, b, acc[j]); }
        }
        if (MODE == 1) {
#pragma unroll
            for (int j = 0; j < 2; ++j) { const int v = 32 * (2 * vp + j) + r;
#pragma unroll
                for (int g = 0; g < 4; ++g) { const int k = 32 * kt + 8 * g + 4 * hh; u32x2 o; o.x = pk2(acc[j][4 * g], acc[j][4 * g + 1]); o.y = pk2(acc[j][4 * g + 2], acc[j][4 * g + 3]);
                    *(u32x2*)(STout + v * 128 + k) = o; } }
            if (tid < 128) DCout[tid] = __expf(BLAST[tid]);
        } else {
#pragma unroll
            for (int j = 0; j < 2; ++j) { const int v = 32 * (2 * vp + j) + r;
#pragma unroll
                for (int g = 0; g < 4; ++g) {
#pragma unroll
                    for (int i = 4 * g; i < 4 * g + 4; ++i) { const int k = 32 * kt + crow(i, hh); snew[k * 128 + v] = __expf(BLAST[k]) * s0[k * 128 + v] + acc[j][i]; }
                    asm volatile("" ::: "memory"); } }
        }
    }
    if (MODE & 2) {
        if (w < 4) {
            const int si = w >> 1, tj = w & 1;
            f32x16 acc;
#pragma unroll
            for (int i = 0; i < 16; ++i) acc[i] = 0.f;
            if (si <= tj) {
#pragma unroll
                for (int s = 0; s < 8; ++s) { const bf16x8 a = *(const LAS bf16x8*)(L + A_KG + swz256(32 * si + r, 2 * s + hh)); const bf16x8 b = *(const LAS bf16x8*)(L + A_QG + swz256(32 * tj + r, 2 * s + hh)); acc = MFMA32(a, b, acc); }
            }
            const int tt = 32 * tj + r;
#pragma unroll
            for (int g = 0; g < 4; ++g) { const int s0_ = 32 * si + 8 * g + 4 * hh; float v[4];
#pragma unroll
                for (int i = 0; i < 4; ++i) v[i] = (s0_ + i <= tt) ? acc[4 * g + i] : 0.f;
                u32x2 o; o.x = pk2(v[0], v[1]); o.y = pk2(v[2], v[3]);
                *(LAS u32x2*)(L + A_ATT + swz128(tt, s0_ >> 3) + (s0_ & 7) * 2) = o; }
        }
        __syncthreads();
        const int vt = w & 3, tj = w >> 2;
        f32x16 acc;
#pragma unroll
        for (int i = 0; i < 16; ++i) acc[i] = 0.f;
#pragma unroll
        for (int s = 0; s < 4; ++s) { const bf16x8 a = *(const LAS bf16x8*)(L + A_VT + swz128(32 * vt + r, 2 * s + hh)); const bf16x8 b = *(const LAS bf16x8*)(L + A_ATT + swz128(32 * tj + r, 2 * s + hh)); acc = MFMA32(a, b, acc); }
        { const bf16* sp = STin + (32 * vt + r) * 128 + 8 * hh;
#pragma unroll
          for (int s = 0; s < 8; ++s) { const bf16x8 a = *(const bf16x8*)(sp + 16 * s); const bf16x8 b = *(const LAS bf16x8*)(L + A_QG + swz256(32 * tj + r, 2 * s + hh)); acc = MFMA32(a, b, acc); } }
        float ssq = 0.f;
#pragma unroll
        for (int i = 0; i < 16; ++i) ssq += acc[i] * acc[i];
        ssq += __shfl_xor(ssq, 32);
        const int tt = 32 * tj + r;
        if (hh == 0) SS[vt * 64 + tt] = ssq;
        __syncthreads();
        const float tot = (SS[tt] + SS[64 + tt]) + (SS[128 + tt] + SS[192 + tt]);
        const float rs = 1.0f / sqrtf(tot * (1.0f / 128.0f) + EPS);
        if (tt < valid) {
            const float* ga = c.in[11] + h * 128;
#pragma unroll
            for (int g = 0; g < 4; ++g) { const int v0 = 32 * vt + 8 * g + 4 * hh; bf16* zp = Z + (size_t)(mrow0 + tt) * ZP + ZC_GA + h * 128 + v0;
                float gg[4]; unpack4(*(const u32x2*)zp, gg); const f32x4 gw = *(const f32x4*)(ga + v0);
                u32x2 o; o.x = pk2(acc[4 * g] * rs * gw.x * gg[0], acc[4 * g + 1] * rs * gw.y * gg[1]); o.y = pk2(acc[4 * g + 2] * rs * gw.z * gg[2], acc[4 * g + 3] * rs * gw.w * gg[3]);
                *(u32x2*)zp = o; }
        }
    }
    __syncthreads();
}

constexpr int B_XCF = 0, B_XCB = 16384, B_RG = 24576, B_IG = 40960, B_AGG = 57344;
template <int MODE>
DI void lru_item(Ctx& c, int b, int j, int n) {
    const int tid = c.tid, lane = c.lane, w = c.wave, r = lane & 31, hh = lane >> 5;
    bf16* Z = WSP(bf16, WS_Z);
    LAS unsigned char* L = c.lds;
    LAS float* XCF = (LAS float*)(L + B_XCF); LAS float* RG = (LAS float*)(L + B_RG); LAS float* IG = (LAS float*)(L + B_IG); LAS float* AGG = (LAS float*)(L + B_AGG);
    const int valid = (MODE == 2) ? 32 : 64;
    const int rowbase = (MODE == 2) ? MP + b * DSEQ : b * SEQ + 64 * j;
    {
        const int t = tid >> 3, c8 = (tid & 7) * 8, ch = n * 64 + c8;
        float xc[8];
        const f32x4 bc0 = *(const f32x4*)(c.in[14] + ch), bc1 = *(const f32x4*)(c.in[14] + ch + 4);
        xc[0] = bc0.x; xc[1] = bc0.y; xc[2] = bc0.z; xc[3] = bc0.w; xc[4] = bc1.x; xc[5] = bc1.y; xc[6] = bc1.z; xc[7] = bc1.w;
#pragma unroll
        for (int jj = 0; jj < 4; ++jj) {
            float x[8];
            const int T = ((MODE == 2) ? 0 : 64 * j) + t + jj - 3;
            if (T >= 0) { unpack8(*(const u32x4*)(Z + (size_t)(rowbase + t + jj - 3) * ZP + ZC_XB + ch), x); }
            else if (MODE == 2) { const float* sc = c.in[6] + (size_t)(b * 3 + (T + 3)) * 1024 + ch; const f32x4 a0 = *(const f32x4*)sc, a1 = *(const f32x4*)(sc + 4);
                x[0] = a0.x; x[1] = a0.y; x[2] = a0.z; x[3] = a0.w; x[4] = a1.x; x[5] = a1.y; x[6] = a1.z; x[7] = a1.w; }
            else {
#pragma unroll
                for (int i = 0; i < 8; ++i) x[i] = 0.f;
            }
            const f32x4 w0 = *(const f32x4*)(c.in[13] + jj * 1024 + ch), w1 = *(const f32x4*)(c.in[13] + jj * 1024 + ch + 4);
            xc[0] += w0.x * x[0]; xc[1] += w0.y * x[1]; xc[2] += w0.z * x[2]; xc[3] += w0.w * x[3]; xc[4] += w1.x * x[4]; xc[5] += w1.y * x[5]; xc[6] += w1.z * x[6]; xc[7] += w1.w * x[7];
        }
        if (t >= valid) {
#pragma unroll
            for (int i = 0; i < 8; ++i) xc[i] = 0.f;
        }
        *(LAS f32x4*)(XCF + t * 64 + c8) = (f32x4){xc[0], xc[1], xc[2], xc[3]}; *(LAS f32x4*)(XCF + t * 64 + c8 + 4) = (f32x4){xc[4], xc[5], xc[6], xc[7]};
        u32x4 o; o.x = pk2(xc[0], xc[1]); o.y = pk2(xc[2], xc[3]); o.z = pk2(xc[4], xc[5]); o.w = pk2(xc[6], xc[7]);
        *(LAS u32x4*)(L + B_XCB + swz128(t, c8 >> 3)) = o;
    }
    __syncthreads();
    {
        const int gate = w >> 2, tt = (w >> 1) & 1, ee = w & 1;
        const bf16* Wt = WSP(bf16, WS_WLRU) + gate * 65536 + (size_t)n * 4096 + (32 * ee + r) * 64 + 8 * hh;
        f32x16 acc;
#pragma unroll
        for (int i = 0; i < 16; ++i) acc[i] = 0.f;
#pragma unroll
        for (int s = 0; s < 4; ++s) { const bf16x8 a = *(const LAS bf16x8*)(L + B_XCB + swz128(32 * tt + r, 2 * s + hh)); const bf16x8 bq = *(const bf16x8*)(Wt + 16 * s); acc = MFMA32(a, bq, acc); }
        const int e = 32 * ee + r; const float bias = (gate ? c.in[18] : c.in[16])[n * 64 + e];
        LAS float* dst = gate ? IG : RG;
#pragma unroll
        for (int i = 0; i < 16; ++i) dst[(32 * tt + crow(i, hh)) * 64 + e] = sigm(acc[i] + bias);
    }
    __syncthreads();
    {
        const int ch = n * 64 + lane;
        const float sp = log1pf(__expf(-c.in[19][ch]));
        float pc[8], hl[8]; float pr = 1.f, hloc = 0.f;
#pragma unroll
        for (int tk = 0; tk < 8; ++tk) {
            const int t = 8 * w + tk;
            const float rg = RG[t * 64 + lane], ig = IG[t * 64 + lane], xc = XCF[t * 64 + lane];
            const float la = -8.0f * rg * sp;
            const float a = __expf(la);
            float mult = sqrtf(-expm1f(2.0f * la));
            if (MODE != 2 && j == 0 && t == 0) mult = 1.0f;
            const float u = mult * ig * xc;
            hloc = a * hloc + u; pr = pr * a; pc[tk] = pr; hl[tk] = hloc;
        }
        AGG[(w * 64 + lane) * 2] = pr; AGG[(w * 64 + lane) * 2 + 1] = hloc;
        __syncthreads();
        float carry = (MODE == 0) ? 0.f : (MODE == 1) ? WSP(float, WS_CIN)[(size_t)(b * 32 + j) * 1024 + ch] : c.in[7][b * 1024 + ch];
        float ptot = 1.f;
#pragma unroll
        for (int ww = 0; ww < 8; ++ww) if (ww < w) { const float p_ = AGG[(ww * 64 + lane) * 2], h_ = AGG[(ww * 64 + lane) * 2 + 1]; carry = p_ * carry + h_; ptot *= p_; }
        if (MODE == 0) {
            if (w == 7) { float* ta = WSP(float, WS_TAGG) + ((size_t)(b * 32 + j) * 1024 + ch) * 2; ta[0] = ptot * pr; ta[1] = hl[7] + pc[7] * carry; }
        } else {
#pragma unroll
            for (int tk = 0; tk < 8; ++tk) {
                const int t = 8 * w + tk;
                if (t < valid) {
                    const float hv = hl[tk] + pc[tk] * carry;
                    bf16* zp = Z + (size_t)(rowbase + t) * ZP + ZC_GB + ch;
                    const float y = hv * bf2f(*zp);
                    *zp = (unsigned short)(pk2(y, 0.f) & 0xffffu);
                    if (MODE == 2 && t == 31) c.out[O_LS + b * 1024 + ch] = hv;
                }
            }
        }
    }
    __syncthreads();
}

DI void attn_wave_item(Ctx& c, int wi) {
    const int lane = c.lane, r = lane & 31, hh = lane >> 5;
    const int rb = wi >> 2, h = wi & 3, m0 = 32 * rb;
    bf16* Z = WSP(bf16, WS_Z);
    const bf16* KB; const bf16* VT;
    if (rb < MP / 32) { const int b = rb >> 6; KB = WSP(bf16, WS_KBP) + (size_t)b * 256 * 512; VT = WSP(bf16, WS_VTP) + (size_t)b * 512 * 256; }
    else { const int b = rb - MP / 32; KB = WSP(bf16, WS_KBS) + (size_t)b * 256 * 512; VT = WSP(bf16, WS_VTS) + (size_t)b * 512 * 256; }
    const bf16* qp = Z + (size_t)(m0 + r) * ZP + ZC_QC + h * 128 + 8 * hh;
    f32x16 O[4];
#pragma unroll
    for (int d = 0; d < 4; ++d)
#pragma unroll
        for (int i = 0; i < 16; ++i) O[d][i] = 0.f;
    float mrun = -INFINITY, l = 0.f;
#pragma unroll 1
    for (int kc = 0; kc < 4; ++kc) {
        f32x16 S[2];
#pragma unroll
        for (int kt = 0; kt < 2; ++kt) {
#pragma unroll
            for (int i = 0; i < 16; ++i) S[kt][i] = 0.f;
            const bf16* kp = KB + (size_t)(64 * kc + 32 * kt + r) * 512 + h * 128 + 8 * hh;
#pragma unroll
            for (int s = 0; s < 8; ++s) { const bf16x8 a = *(const bf16x8*)(kp + 16 * s); const bf16x8 qf = *(const bf16x8*)(qp + 16 * s); S[kt] = MFMA32(a, qf, S[kt]); }
        }
        float mx = S[0][0];
#pragma unroll
        for (int i = 0; i < 16; ++i) { mx = fmaxf(mx, S[0][i]); mx = fmaxf(mx, S[1][i]); }
        mx = fmaxf(mx, __shfl_xor(mx, 32));
        const float mnew = fmaxf(mrun, mx);
        const float alpha = exp2f(mrun - mnew);
        mrun = mnew; l *= alpha;
#pragma unroll
        for (int d = 0; d < 4; ++d)
#pragma unroll
            for (int i = 0; i < 16; ++i) O[d][i] *= alpha;
#pragma unroll
        for (int kt = 0; kt < 2; ++kt)
#pragma unroll
            for (int i = 0; i < 16; ++i) { const float p = exp2f(S[kt][i] - mnew); S[kt][i] = p; l += p; }
#pragma unroll
        for (int kt = 0; kt < 2; ++kt)
#pragma unroll
            for (int s2 = 0; s2 < 2; ++s2) {
                u32x4 pw; pw.x = pk2(S[kt][8 * s2], S[kt][8 * s2 + 1]); pw.y = pk2(S[kt][8 * s2 + 2], S[kt][8 * s2 + 3]); pw.z = pk2(S[kt][8 * s2 + 4], S[kt][8 * s2 + 5]); pw.w = pk2(S[kt][8 * s2 + 6], S[kt][8 * s2 + 7]);
                const bf16x8 pb = __builtin_bit_cast(bf16x8, pw);
                const int key0 = 64 * kc + 32 * kt + 16 * s2 + 4 * hh;
#pragma unroll
                for (int d = 0; d < 4; ++d) { const bf16* vp = VT + (size_t)(h * 128 + 32 * d + r) * 256 + key0; const u32x2 lo = *(const u32x2*)vp, hi = *(const u32x2*)(vp + 8);
                    u32x4 av; av.x = lo.x; av.y = lo.y; av.z = hi.x; av.w = hi.y; O[d] = MFMA32(__builtin_bit_cast(bf16x8, av), pb, O[d]); }
            }
    }
    l += __shfl_xor(l, 32);
    const float inv = 1.0f / l;
#pragma unroll
    for (int d = 0; d < 4; ++d)
#pragma unroll
        for (int g = 0; g < 4; ++g) { const int d0 = 32 * d + 8 * g + 4 * hh; bf16* zp = Z + (size_t)(m0 + r) * ZP + ZC_GC + h * 128 + d0;
            float gg[4]; unpack4(*(const u32x2*)zp, gg);
            u32x2 o; o.x = pk2(O[d][4 * g] * inv * gg[0], O[d][4 * g + 1] * inv * gg[1]); o.y = pk2(O[d][4 * g + 2] * inv * gg[2], O[d][4 * g + 3] * inv * gg[3]);
            *(u32x2*)zp = o; }
}

constexpr int N_A_P = 1024, N_B_P = 4096, N_C = 260, N_A_S = 32, N_B_S = 128;
DI void phase_p2a(Ctx& c) {
    bf16* ST = (bf16*)c.out;
    for (int it = c.bid; it < N_A_P + N_B_P + N_C; it += c.G) {
        if (it < N_A_P) { const int b = it >> 7, cc = (it >> 2) & 31, h = it & 3;
            hgrn_item<1>(c, b * SEQ + 64 * cc, 64, h, nullptr, ST + (size_t)it * 16384, WSP(float, WS_DC) + it * 128, nullptr, nullptr); }
        else if (it < N_A_P + N_B_P) { const int i = it - N_A_P, b = i >> 9, j = (i >> 4) & 31, n = i & 15; lru_item<0>(c, b, j, n); }
        else { const int i = it - N_A_P - N_B_P; attn_wave_item(c, i * 8 + c.wave); }
    }
}
DI void phase_p2b(Ctx& c) {
    bf16* ST = (bf16*)c.out;
    for (int e = c.bid * 512 + c.tid; e < 65536 + 8192; e += c.G * 512) {
        if (e < 65536) {
            const int v = e & 127, kg = (e >> 7) & 15, bh = e >> 11, b = bh >> 2, h = bh & 3;
            float s[8];
#pragma unroll
            for (int i = 0; i < 8; ++i) s[i] = 0.f;
            for (int cc = 0; cc < 32; ++cc) {
                const int item = (b * 32 + cc) * 4 + h;
                u32x4* p = (u32x4*)(ST + (size_t)item * 16384 + v * 128 + kg * 8);
                float kv[8]; unpack8(*p, kv);
                u32x4 o; o.x = pk2(s[0], s[1]); o.y = pk2(s[2], s[3]); o.z = pk2(s[4], s[5]); o.w = pk2(s[6], s[7]); *p = o;
                const float* dc = WSP(float, WS_DC) + item * 128 + kg * 8;
#pragma unroll
                for (int i = 0; i < 8; ++i) s[i] = dc[i] * s[i] + kv[i];
            }
#pragma unroll
            for (int i = 0; i < 8; ++i) c.out[O_HP + ((size_t)bh * 128 + kg * 8 + i) * 128 + v] = s[i];
        } else {
            const int e2 = e - 65536, b = e2 >> 10, ch = e2 & 1023; float carry = 0.f;
            for (int j = 0; j < 32; ++j) { const size_t ix = (size_t)(b * 32 + j) * 1024 + ch; WSP(float, WS_CIN)[ix] = carry; const float* ta = WSP(float, WS_TAGG) + ix * 2; carry = ta[0] * carry + ta[1]; }
            c.out[O_LP + b * 1024 + ch] = carry;
        }
    }
}
DI void phase_p2c(Ctx& c) {
    bf16* ST = (bf16*)c.out;
    for (int it = c.bid; it < N_A_P + N_A_S + N_B_P + N_B_S; it += c.G) {
        if (it < N_A_P) { const int b = it >> 7, cc = (it >> 2) & 31, h = it & 3;
            hgrn_item<2>(c, b * SEQ + 64 * cc, 64, h, ST + (size_t)it * 16384, nullptr, nullptr, nullptr, nullptr); }
        else if (it < N_A_P + N_A_S) { const int i = it - N_A_P, b = i >> 2, h = i & 3;
            hgrn_item<3>(c, MP + b * DSEQ, 32, h, WSP(bf16, WS_ST0) + (size_t)i * 16384, nullptr, nullptr, c.in[5] + (size_t)i * 16384, c.out + O_HS + (size_t)i * 16384); }
        else if (it < N_A_P + N_A_S + N_B_P) { const int i = it - N_A_P - N_A_S, b = i >> 9, j = (i >> 4) & 31, n = i & 15; lru_item<1>(c, b, j, n); }
        else { const int i = it - N_A_P - N_A_S - N_B_P, b = i >> 4, n = i & 15; lru_item<2>(c, b, 0, n); }
    }
}

struct Args { const float* in[27]; float* out; unsigned char* ws; int ph_lo, ph_hi; };
constexpr int N_PHASES = 8;
__global__ void __launch_bounds__(512, 2) mk_fwd(Args a) {
    extern __shared__ __attribute__((aligned(16))) unsigned char lds_raw[];
    Ctx c;
    c.lds = (LAS unsigned char*)lds_raw;
    c.tid = threadIdx.x; c.lane = c.tid & 63; c.wave = __builtin_amdgcn_readfirstlane(c.tid >> 6);
    c.G = gridDim.x; c.bid = blockIdx.x;
#pragma unroll
    for (int i = 0; i < 27; ++i) c.in[i] = a.in[i];
    c.out = a.out; c.ws = a.ws;
    volatile LAS unsigned* MISC = (volatile LAS unsigned*)(c.lds + MISC_OFF);
    if (c.tid < 64) MISC[c.tid] = 0u;
    __syncthreads();
    XcdBarrier bar; bar.bar = (unsigned*)(a.ws + WS_CTL) + 1024; bar.x = 0; bar.st = nullptr;
    if (MK_N_LAUNCHES == 1) bar = xcd_barrier_post((unsigned*)(a.ws + WS_CTL) + 1024, MISC + 8);
    const int lo = a.ph_lo, hi = a.ph_hi;
#define IN(k) (lo <= (k) && (k) < hi)
#define SEAM(k) do { if (IN(k) && IN((k) + 1)) xcd_barrier(bar); } while (0)
    if (IN(0)) phase_prologue(c);
    SEAM(0);
    if (IN(1)) phase_g1(c);
    SEAM(1);
    if (IN(2)) phase_p2a(c);
    SEAM(2);
    if (IN(3)) phase_p2b(c);
    SEAM(3);
    if (IN(4)) phase_p2c(c);
    SEAM(4);
    if (IN(5)) phase_g3(c);
    SEAM(5);
    if (IN(6)) phase_g4(c);
    SEAM(6);
    if (IN(7)) phase_final(c);
#undef IN
#undef SEAM
}

extern "C" void kernel_launch(void* const* d_in, const int* in_sizes, int n_in, void* d_out, int out_size, void* d_ws, size_t ws_size, hipStream_t stream) {
    static int grid = 0;
    if (grid == 0) {
        if (n_in != 27 || ws_size < WS_END) { fprintf(stderr, "kernel_launch: unexpected n_in %d / ws_size %zu (need %zu)\n", n_in, ws_size, (size_t)WS_END); grid = -1; return; }
        int dev = 0, cus = 0, per_cu = 0;
        if (hipGetDevice(&dev) != hipSuccess || hipDeviceGetAttribute(&cus, hipDeviceAttributeMultiprocessorCount, dev) != hipSuccess) { grid = -1; return; }
        if (hipFuncSetAttribute((const void*)mk_fwd, hipFuncAttributeMaxDynamicSharedMemorySize, LDS_BYTES) != hipSuccess) { fprintf(stderr, "kernel_launch: hipFuncSetAttribute failed\n"); grid = -1; return; }
        if (hipOccupancyMaxActiveBlocksPerMultiprocessor(&per_cu, (const void*)mk_fwd, 512, LDS_BYTES) != hipSuccess || per_cu < 1) { fprintf(stderr, "kernel_launch: occupancy query says %d\n", per_cu); per_cu = 1; }
        (void)hipGetLastError();
        grid = cus;
    }
    if (grid < 0) return;
    (void)hipMemsetAsync((char*)d_ws + WS_CTL, 0, CTL_ZERO_BYTES, stream);
    Args a{};
    for (int i = 0; i < 27; ++i) a.in[i] = (const float*)d_in[i];
    a.out = (float*)d_out; a.ws = (unsigned char*)d_ws;
    if (MK_N_LAUNCHES == 1) {
        a.ph_lo = 0; a.ph_hi = N_PHASES;
        hipLaunchKernelGGL(mk_fwd, dim3(grid), dim3(512), LDS_BYTES, stream, a);
    } else {
        for (int p = 0; p < N_PHASES; ++p) { a.ph_lo = p; a.ph_hi = p + 1; hipLaunchKernelGGL(mk_fwd, dim3(grid), dim3(512), LDS_BYTES, stream, a); }
    }
}
```

```cpp
#include <hip/hip_runtime.h>
#include <cstdio>
#include <cstdint>

#ifndef MK_N_LAUNCHES
#define MK_N_LAUNCHES 1
#endif

#define PROBE_REP -1
#define DI __device__ __forceinline__
#define LAS __attribute__((address_space(3)))
typedef unsigned short bf16;
typedef short bf16x8 __attribute__((ext_vector_type(8)));
typedef float f32x16 __attribute__((ext_vector_type(16)));
typedef float f32x4 __attribute__((ext_vector_type(4)));
typedef float f32x2 __attribute__((ext_vector_type(2)));
typedef unsigned u32x4 __attribute__((ext_vector_type(4)));
typedef unsigned u32x2 __attribute__((ext_vector_type(2)));
typedef __bf16 bf16x2_t __attribute__((ext_vector_type(2)));

constexpr int DM = 1024, NB = 8, SEQ = 2048, DSEQ = 32, NMEM = 256;
constexpr int MP = NB * SEQ, MS = NB * DSEQ, MT = MP + MS;
constexpr int ZP = 5120;
constexpr int ZC_QA = 0, ZC_FA = 512, ZC_VA = 1024, ZC_GA = 1536, ZC_XB = 2048, ZC_GB = 3072, ZC_QC = 4096, ZC_GC = 4608;
constexpr int ZC_MG = 0;
constexpr float EPS = 1e-6f;
constexpr float QSCALE = 0.08838834764831845f * 1.4426950408889634f;

constexpr size_t O_YP = 0, O_YS = 16777216, O_HP = 17039360, O_CP = 17563648, O_LP = 17588224, O_MK = 17596416, O_MV = 18644992,
                 O_HS = 19693568, O_CS = 20217856, O_LS = 20242432;

constexpr size_t MiB = 1u << 20;
constexpr size_t WS_CTL = 0, CTL_ZERO_BYTES = 64 * 1024;
constexpr size_t WS_WIN = 1 * MiB, WS_WA = 17 * MiB, WS_WB = 19 * MiB, WS_WC = 21 * MiB, WS_WOUT = 23 * MiB, WS_WMEM = 25 * MiB,
                 WS_WLRU = 27 * MiB, WS_TAGG = 28 * MiB, WS_CIN = 30 * MiB, WS_DC = 31 * MiB, WS_ST0 = 32 * MiB, WS_KBP = 33 * MiB,
                 WS_VTP = 35 * MiB, WS_KBS = 37 * MiB, WS_VTS = 39 * MiB, WS_HM = 41 * MiB, WS_H = 45 * MiB, WS_Z = 78 * MiB;
constexpr size_t WS_END = WS_Z + (size_t)MT * ZP * 2;
static_assert(WS_H + (size_t)MT * DM * 2 <= WS_Z && WS_END <= 256 * MiB, "ws map");

constexpr int LDS_BYTES = 147456;
constexpr int MISC_OFF = 131072;

DI float bf2f(unsigned short b) { return __uint_as_float((unsigned)b << 16); }
DI unsigned pk2(float lo, float hi) { f32x2 v = {lo, hi}; bf16x2_t b = __builtin_convertvector(v, bf16x2_t); return __builtin_bit_cast(unsigned, b); }
DI float sigm(float x) { return 1.0f / (1.0f + __expf(-x)); }
DI float silu(float x) { return x * sigm(x); }
DI void unpack8(const u32x4 w, float (&f)[8]) {
    f[0] = __uint_as_float(w.x << 16); f[1] = __uint_as_float(w.x & 0xffff0000u);
    f[2] = __uint_as_float(w.y << 16); f[3] = __uint_as_float(w.y & 0xffff0000u);
    f[4] = __uint_as_float(w.z << 16); f[5] = __uint_as_float(w.z & 0xffff0000u);
    f[6] = __uint_as_float(w.w << 16); f[7] = __uint_as_float(w.w & 0xffff0000u);
}
DI void unpack4(const u32x2 w, float (&f)[4]) {
    f[0] = __uint_as_float(w.x << 16); f[1] = __uint_as_float(w.x & 0xffff0000u);
    f[2] = __uint_as_float(w.y << 16); f[3] = __uint_as_float(w.y & 0xffff0000u);
}
DI int crow(int reg, int h) { return (reg & 3) + 8 * (reg >> 2) + 4 * h; }
#define MFMA32(a, b, c) __builtin_amdgcn_mfma_f32_32x32x16_bf16((a), (b), (c), 0, 0, 0)
DI float wave_sum(float v) {
#pragma unroll
    for (int o = 1; o < 64; o <<= 1) v += __shfl_xor(v, o);
    return v;
}

struct Ctx {
    LAS unsigned char* lds;
    int tid, lane, wave, G, bid;
    const float* in[27];
    float* out;
    unsigned char* ws;
};
#define WSP(T, off) ((T*)(c.ws + (off)))

#define XB_TMO      128
#define XB_XCNT(j)  (256  + 64 * (j))
#define XB_XSUB(j)  (1280 + 64 * (j))
#define XB_XGEN(j)  (2304 + 64 * (j))
#define XB_TOP      3328
#define XB_TOPGEN   3392
#define XCD_BAR_WORDS 3456
#define XB_SPIN_CAP (1u << 18)
DI unsigned xb_ld(unsigned* p)              { return __hip_atomic_load(p, __ATOMIC_RELAXED, __HIP_MEMORY_SCOPE_AGENT); }
DI unsigned xb_add(unsigned* p, unsigned v) { return __hip_atomic_fetch_add(p, v, __ATOMIC_RELAXED, __HIP_MEMORY_SCOPE_AGENT); }
DI unsigned xb_xcc_id() { return (unsigned)__builtin_amdgcn_s_getreg((3 << 11) | 20) & 0xFu; }
#define XB_SPIN(cond, bar) do { unsigned _sp = 0; while (cond) { __builtin_amdgcn_s_sleep(1); \
    if ((++_sp & 255u) == 0u) { if (xb_ld(&(bar)[XB_TMO])) break; if (_sp > XB_SPIN_CAP) { atomicAdd(&(bar)[XB_TMO], 1u); break; } } } } while (0)
struct XcdBarrier { unsigned* bar; unsigned x; volatile LAS unsigned* st; };
DI XcdBarrier xcd_barrier_post(unsigned* bar, volatile LAS unsigned* st) {
    XcdBarrier b; b.bar = bar; b.x = xb_xcc_id(); b.st = st;
    if (threadIdx.x == 0) (void)xb_add(&bar[XB_XCNT(b.x)], 1u);
    return b;
}
DI void xcd_barrier_complete(unsigned* bar, unsigned x, unsigned& nloc, unsigned& nx) {
    const unsigned G = gridDim.x * gridDim.y * gridDim.z;
    unsigned sum, cnt, mine, sp = 0u;
    for (;;) {
        sum = 0u; cnt = 0u; mine = 0u;
#pragma unroll
        for (unsigned j = 0; j < 16; ++j) { const unsigned c = xb_ld(&bar[XB_XCNT(j)]); sum += c; cnt += (c > 0u) ? 1u : 0u; mine = (j == x) ? c : mine; }
        if (sum == G) break;
        __builtin_amdgcn_s_sleep(1);
        if ((++sp & 255u) == 0u) { if (xb_ld(&bar[XB_TMO])) break; if (sp > XB_SPIN_CAP) { atomicAdd(&bar[XB_TMO], 1u); break; } }
    }
    nloc = mine > 0u ? mine : 1u; nx = cnt > 0u ? cnt : 1u;
}
DI void xcd_barrier(const XcdBarrier& b) {
    asm volatile("s_waitcnt vmcnt(0)" ::: "memory");
    __syncthreads();
    if (threadIdx.x == 0) {
        unsigned* bar = b.bar;
        __builtin_amdgcn_s_waitcnt(0);
        unsigned nloc = b.st[0], nx = b.st[1];
        if (nloc == 0u) { xcd_barrier_complete(bar, b.x, nloc, nx); b.st[0] = nloc; b.st[1] = nx; }
        const unsigned old = xb_add(&bar[XB_XSUB(b.x)], 1u);
        const unsigned gen = old / nloc;
        if (old + 1u == (gen + 1u) * nloc) {
            __builtin_amdgcn_fence(__ATOMIC_RELEASE, "agent");
            asm volatile("s_waitcnt vmcnt(0)" ::: "memory");
            const unsigned og = xb_add(&bar[XB_TOP], 1u);
            const unsigned tg = og / nx;
            if (og + 1u == (tg + 1u) * nx) xb_add(&bar[XB_TOPGEN], 1u);
            else XB_SPIN(xb_ld(&bar[XB_TOPGEN]) == tg, bar);
            __builtin_amdgcn_fence(__ATOMIC_ACQUIRE, "agent");
            xb_add(&bar[XB_XGEN(b.x)], 1u);
            asm volatile("s_waitcnt vmcnt(0)" ::: "memory");
        } else {
            XB_SPIN(xb_ld(&bar[XB_XGEN(b.x)]) == gen, bar);
            __builtin_amdgcn_fence(__ATOMIC_ACQUIRE, "agent");
            asm volatile("s_waitcnt vmcnt(0)" ::: "memory");
        }
    }
    __syncthreads();
}

DI void p0_transpose_item(const float* W, int K, int N, bf16* WT, int ldt, int row_off, LAS float* scr, int item, int lane) {
    const int nblk = N / 32, kb = item / nblk, nb = item % nblk, k0 = 64 * kb, n0 = 32 * nb;
#pragma unroll 8
    for (int i = 0; i < 32; ++i) { const int kk = 2 * i + (lane >> 5); scr[kk * 33 + (lane & 31)] = W[(size_t)(k0 + kk) * N + n0 + (lane & 31)]; }
    asm volatile("s_waitcnt lgkmcnt(0)" ::: "memory");
    const int cc = lane & 7;
#pragma unroll
    for (int j = 0; j < 4; ++j) { const int n = (lane >> 3) + 8 * j; const LAS float* s = scr + (8 * cc) * 33 + n;
        u32x4 o; o.x = pk2(s[0 * 33], s[1 * 33]); o.y = pk2(s[2 * 33], s[3 * 33]); o.z = pk2(s[4 * 33], s[5 * 33]); o.w = pk2(s[6 * 33], s[7 * 33]);
        *(u32x4*)(WT + (size_t)(row_off + n0 + n) * ldt + k0 + 8 * cc) = o; }
    asm volatile("s_waitcnt lgkmcnt(0)" ::: "memory");
}
DI void rms_row_to_bf16(const float* xrow, const float* g, bf16* orow, int lane) {
    const f32x4* xr = (const f32x4*)xrow + lane; const f32x4* gr = (const f32x4*)g + lane;
    f32x4 v[4]; float s = 0.f;
#pragma unroll
    for (int j = 0; j < 4; ++j) { v[j] = xr[64 * j]; s += (v[j].x * v[j].x + v[j].y * v[j].y) + (v[j].z * v[j].z + v[j].w * v[j].w); }
    const float rs = 1.0f / sqrtf(wave_sum(s) * (1.f / DM) + EPS);
    u32x2* o8 = (u32x2*)orow + lane;
#pragma unroll
    for (int j = 0; j < 4; ++j) { const f32x4 gg = gr[64 * j]; u32x2 w; w.x = pk2(v[j].x * rs * gg.x, v[j].y * rs * gg.y); w.y = pk2(v[j].z * rs * gg.z, v[j].w * rs * gg.w); o8[64 * j] = w; }
}
DI void phase_prologue(Ctx& c) {
    LAS float* scr = (LAS float*)(c.lds + c.wave * 16384);
    const int gw = c.bid * 8 + c.wave, NGW = c.G * 8;
    constexpr int I_WIN = 16 * 256, I_WA = 8 * 32, I_WB = 16 * 32, I_WC = 8 * 32, I_WO = 16 * 32, I_MK = 16 * 16, I_MV = 16 * 16, I_LR = 32, I_LI = 32, I_ST = 32 * 8, I_VS = 8 * 64;
    constexpr int NITEMS = I_WIN + I_WA + I_WB + I_WC + I_WO + I_MK + I_MV + I_LR + I_LI + I_ST + I_VS;
    for (int it = gw; it < NITEMS; it += NGW) {
        int r = it;
        if (r < I_WIN) { p0_transpose_item(c.in[9], 1024, 8192, WSP(bf16, WS_WIN), 1024, 0, scr, r, c.lane); continue; } r -= I_WIN;
        if (r < I_WA) { p0_transpose_item(c.in[12], 512, 1024, WSP(bf16, WS_WA), 1024, 0, scr, r, c.lane); continue; } r -= I_WA;
        if (r < I_WB) { p0_transpose_item(c.in[20], 1024, 1024, WSP(bf16, WS_WB), 1024, 0, scr, r, c.lane); continue; } r -= I_WB;
        if (r < I_WC) { p0_transpose_item(c.in[24], 512, 1024, WSP(bf16, WS_WC), 1024, 0, scr, r, c.lane); continue; } r -= I_WC;
        if (r < I_WO) { p0_transpose_item(c.in[25], 1024, 1024, WSP(bf16, WS_WOUT), 1024, 0, scr, r, c.lane); continue; } r -= I_WO;
        if (r < I_MK) { p0_transpose_item(c.in[22], 1024, 512, WSP(bf16, WS_WMEM), 1024, 0, scr, r, c.lane); continue; } r -= I_MK;
        if (r < I_MV) { p0_transpose_item(c.in[23], 1024, 512, WSP(bf16, WS_WMEM), 1024, 512, scr, r, c.lane); continue; } r -= I_MV;
        if (r < I_LR) { const int n = r >> 1; p0_transpose_item(c.in[15] + n * 4096, 64, 64, WSP(bf16, WS_WLRU) + n * 4096, 64, 0, scr, r & 1, c.lane); continue; } r -= I_LR;
        if (r < I_LI) { const int n = r >> 1; p0_transpose_item(c.in[17] + n * 4096, 64, 64, WSP(bf16, WS_WLRU) + 65536 + n * 4096, 64, 0, scr, r & 1, c.lane); continue; } r -= I_LI;
        if (r < I_ST) { const int bh = r >> 3; p0_transpose_item(c.in[5] + (size_t)bh * 16384, 128, 128, WSP(bf16, WS_ST0) + (size_t)bh * 16384, 128, 0, scr, r & 7, c.lane); continue; } r -= I_ST;
        { const int b = r >> 6; p0_transpose_item(c.in[4] + (size_t)b * 131072, 256, 512, WSP(bf16, WS_VTS) + (size_t)b * 131072, 256, 0, scr, r & 63, c.lane); }
    }
    for (int m = gw; m < MT + NB * NMEM; m += NGW) {
        if (m < MP) rms_row_to_bf16(c.in[0] + (size_t)m * DM, c.in[8], WSP(bf16, WS_H) + (size_t)m * DM, c.lane);
        else if (m < MT) rms_row_to_bf16(c.in[1] + (size_t)(m - MP) * DM, c.in[8], WSP(bf16, WS_H) + (size_t)m * DM, c.lane);
        else rms_row_to_bf16(c.in[2] + (size_t)(m - MT) * DM, c.in[21], WSP(bf16, WS_HM) + (size_t)(m - MT) * DM, c.lane);
    }
    { const size_t n8 = (size_t)NB * NMEM * 512 / 8; const f32x4* src = (const f32x4*)c.in[3]; u32x4* dst = WSP(u32x4, WS_KBS);
      for (size_t i = (size_t)c.bid * 512 + c.tid; i < n8; i += (size_t)c.G * 512) { const f32x4 a = src[2 * i], b = src[2 * i + 1]; u32x4 o; o.x = pk2(a.x, a.y); o.y = pk2(a.z, a.w); o.z = pk2(b.x, b.y); o.w = pk2(b.z, b.w); dst[i] = o; } }
}

DI int swz128(int row, int chunk) { return row * 128 + ((chunk ^ ((row >> 1) & 7)) << 4); }
DI void gemm_kloop(Ctx& c, f32x16 (&acc)[2], const bf16* A, int lda, const bf16* Bt, int ldb, int K, int m0, int n0) {
    const int tid = c.tid, lane = c.lane, w = c.wave, wr = w >> 1, wc = w & 1, r = lane & 31, h = lane >> 5;
    const int srow = tid >> 2, scp = tid & 3;
    const bf16* ga = A + (size_t)(m0 + srow) * lda + scp * 16;
    const bf16* gb = Bt + (size_t)(n0 + srow) * ldb + scp * 16;
    const int wo0 = swz128(srow, 2 * scp), wo1 = swz128(srow, 2 * scp + 1);
    const int nk = K / 64;
    u32x4 ra0, ra1, rb0, rb1;
    ra0 = *(const u32x4*)(ga); ra1 = *(const u32x4*)(ga + 8); rb0 = *(const u32x4*)(gb); rb1 = *(const u32x4*)(gb + 8);
    __syncthreads();
    *(LAS u32x4*)(c.lds + wo0) = ra0; *(LAS u32x4*)(c.lds + wo1) = ra1; *(LAS u32x4*)(c.lds + 16384 + wo0) = rb0; *(LAS u32x4*)(c.lds + 16384 + wo1) = rb1;
    __syncthreads();
    for (int kt = 0; kt < nk; ++kt) {
        const int cur = (kt & 1) * 32768, nxt = 32768 - cur;
        if (kt + 1 < nk) { const bf16* pa = ga + (kt + 1) * 64; const bf16* pb = gb + (kt + 1) * 64;
            ra0 = *(const u32x4*)(pa); ra1 = *(const u32x4*)(pa + 8); rb0 = *(const u32x4*)(pb); rb1 = *(const u32x4*)(pb + 8); }
#pragma unroll
        for (int s = 0; s < 4; ++s) {
            const bf16x8 af = *(const LAS bf16x8*)(c.lds + cur + swz128(32 * wr + r, 2 * s + h));
#pragma unroll
            for (int j = 0; j < 2; ++j) {
                const bf16x8 bfr = *(const LAS bf16x8*)(c.lds + cur + 16384 + swz128(64 * wc + 32 * j + r, 2 * s + h));
                acc[j] = MFMA32(bfr, af, acc[j]);
            }
        }
        if (kt + 1 < nk) { *(LAS u32x4*)(c.lds + nxt + wo0) = ra0; *(LAS u32x4*)(c.lds + nxt + wo1) = ra1; *(LAS u32x4*)(c.lds + nxt + 16384 + wo0) = rb0; *(LAS u32x4*)(c.lds + nxt + 16384 + wo1) = rb1; }
        __syncthreads();
    }
}
template <class Epi> DI void gemm_epi(Ctx& c, const f32x16 (&acc)[2], int m0, int n0, const Epi& E) {
    const int lane = c.lane, w = c.wave, wr = w >> 1, wc = w & 1, r = lane & 31, h = lane >> 5;
    const int m = m0 + 32 * wr + r;
#pragma unroll
    for (int j = 0; j < 2; ++j)
#pragma unroll
        for (int g = 0; g < 4; ++g) { const int n = n0 + 64 * wc + 32 * j + 8 * g + 4 * h; E(m, n, (f32x4){acc[j][4 * g], acc[j][4 * g + 1], acc[j][4 * g + 2], acc[j][4 * g + 3]}); }
}
template <class Epi> DI void gemm_tile(Ctx& c, const bf16* A, int lda, const bf16* Bt, int ldb, int K, int m0, int n0, const Epi& E) {
    f32x16 acc[2];
#pragma unroll
    for (int j = 0; j < 2; ++j)
#pragma unroll
        for (int i = 0; i < 16; ++i) acc[j][i] = 0.f;
    gemm_kloop(c, acc, A, lda, Bt, ldb, K, m0, n0);
    gemm_epi(c, acc, m0, n0, E);
}

struct EpiZ {
    bf16* Z; float* out;
    DI void operator()(int m, int n, f32x4 v) const {
        if (n >= ZC_XB && n < ZC_GB) {
            int b, t3;
            if (m < MP) { b = m >> 11; t3 = (m & 2047) - 2045; } else { b = (m - MP) >> 5; t3 = ((m - MP) & 31) - 29; }
            if (t3 >= 0) { float* o = out + (m < MP ? O_CP : O_CS) + (size_t)(b * 3 + t3) * 1024 + (n - ZC_XB); *(f32x4*)o = v; }
        }
        const bool act = (n < ZC_FA) || (n >= ZC_GA && n < ZC_XB) || (n >= ZC_GB && n < ZC_QC) || (n >= ZC_GC);
        if (act) { v.x = silu(v.x); v.y = silu(v.y); v.z = silu(v.z); v.w = silu(v.w); }
        if (n >= ZC_QC && n < ZC_GC) { v = v * QSCALE; }
        u32x2 o; o.x = pk2(v.x, v.y); o.y = pk2(v.z, v.w);
        *(u32x2*)(Z + (size_t)m * ZP + n) = o;
    }
};
struct EpiMK {
    bf16* KB; float* out;
    DI void operator()(int m, int n, f32x4 v) const {
        *(f32x4*)(out + O_MK + (size_t)m * 512 + n) = v;
        u32x2 o; o.x = pk2(v.x, v.y); o.y = pk2(v.z, v.w); *(u32x2*)(KB + (size_t)m * 512 + n) = o;
    }
};
struct EpiMV {
    bf16* VT; float* out;
    DI void operator()(int nn, int m, f32x4 v) const {
        float* o = out + O_MV + (size_t)m * 512 + nn; o[0] = v.x; o[512] = v.y; o[1024] = v.z; o[1536] = v.w;
        const int b = m >> 8; u32x2 p; p.x = pk2(v.x, v.y); p.y = pk2(v.z, v.w);
        *(u32x2*)(VT + ((size_t)b * 512 + nn) * 256 + (m & 255)) = p;
    }
};
struct EpiMG { bf16* Z; DI void operator()(int m, int n, f32x4 v) const { u32x2 o; o.x = pk2(v.x, v.y); o.y = pk2(v.z, v.w); *(u32x2*)(Z + (size_t)m * ZP + ZC_MG + n) = o; } };
struct EpiY {
    const float* xp; const float* xs; float* out;
    DI void operator()(int m, int n, f32x4 v) const {
        const float* x = (m < MP) ? xp + (size_t)m * DM + n : xs + (size_t)(m - MP) * DM + n;
        const f32x4 xv = *(const f32x4*)x;
        *(f32x4*)(out + (size_t)m * DM + n) = xv + v;
    }
};


namespace pgx {
constexpr int BM = 256, BK = 64, HALF = 128, HTB = HALF * BK * 2, STAGE_BYTES = 8 * HTB, NXCD = 8, WGM = 8;
DI int lds_byte(int r, int c) { const int st = (r >> 4) * 2 + (c >> 5), rr = r & 15, cc = c & 31, ob = rr * 64 + cc * 2; return st * 1024 + (ob ^ (((ob >> 9) & 1) << 5)); }
DI void stage_rc(int b, int& R, int& C) { const int st = b / 1024, sb = b % 1024, swz = sb ^ (((sb >> 9) & 1) << 5); R = (st >> 1) * 16 + swz / 64; C = (st & 1) * 32 + (swz % 64) / 2; }
DI int perm32(int rho) { const int n = rho >> 4, i = rho & 15; return 8 * (i >> 2) + 4 * n + (i & 3); }
struct Unit { const char* A; const char* B; int nt, pm, pn, seg, za; };
DI bool static_tile(int i, int G, int c, int nM, int nN, int& pm, int& pn) {
    const int nwg = nM * nN; const long L = (long)i * G + c; if (L >= nwg) return false;
    int wgid = (int)L; { const int q = nwg / NXCD, r = nwg % NXCD, xcd = wgid % NXCD, off = wgid / NXCD; wgid = (xcd < r ? xcd * (q + 1) : r * (q + 1) + (xcd - r) * q) + off; }
    const int nig = WGM * nN, gid = wgid / nig, fm = gid * WGM, gsz = (nM - fm) < WGM ? (nM - fm) : WGM;
    pm = fm + ((wgid % nig) % gsz); pn = (wgid % nig) / gsz; return true;
}
template <class Epi, class Sched>
DI void gemm_phase(LAS unsigned char* lds, const int lda0, const int lda1, const int ldb, const Sched& S, Epi& E) {
    const int tid = threadIdx.x, wid = __builtin_amdgcn_readfirstlane(tid >> 6), lane = tid & 63, wr = wid >> 2, wc = wid & 3, fr = lane & 15, fq = lane >> 4;
    unsigned vA0[2], vA1[2], voffB[2];
#pragma unroll
    for (int i = 0; i < 2; ++i) { int R, C; stage_rc(tid * 16 + i * 8192, R, C); const int Rb = Epi::PERM ? ((R & ~31) + perm32(R & 31)) : R;
        vA0[i] = (unsigned)(R * lda0 + C) * 2u; vA1[i] = (unsigned)(R * lda1 + C) * 2u; voffB[i] = (unsigned)(Rb * ldb + C) * 2u; }
    const size_t kstep = (size_t)(BK * 2);
    const size_t hsA0 = (size_t)HALF * lda0 * 2, hsA1 = (size_t)HALF * lda1 * 2, hstepB = (size_t)HALF * ldb * 2;
    const unsigned ldsw = (unsigned)wid * 1024u;
    const int aoff = lds_byte(wr * 64 + fr, fq * 8), boff = lds_byte(wc * 32 + fr, fq * 8);
#define PG8_SA(b, h) (((b) * 2 + (h)) * HTB)
#define PG8_SB(b, h) ((4 + (b) * 2 + (h)) * HTB)
#define PG8_STAGE(bufoff, gbase, voff) do { _Pragma("unroll") for (int _i = 0; _i < 2; ++_i) \
        __builtin_amdgcn_global_load_lds((const unsigned*)((const char*)(gbase) + (voff)[_i]), (LAS unsigned*)(lds + (bufoff) + ldsw + _i * 8192), 16, 0, 0); } while (0)
#define PG8_LDA(dst, b, h) do { _Pragma("unroll") for (int m = 0; m < 4; ++m) _Pragma("unroll") for (int k = 0; k < 2; ++k) dst[m][k] = *(const LAS bf16x8*)(lds + PG8_SA(b, h) + aoff + m * 2048 + k * 1024); } while (0)
#define PG8_LDB(dst, b, h) do { _Pragma("unroll") for (int n = 0; n < 2; ++n) _Pragma("unroll") for (int k = 0; k < 2; ++k) dst[n][k] = *(const LAS bf16x8*)(lds + PG8_SB(b, h) + boff + n * 2048 + k * 1024); } while (0)
#define PG8_MMA(ai, bj, At, Bt) do { __builtin_amdgcn_s_setprio(1); _Pragma("unroll") for (int m = 0; m < 4; ++m) _Pragma("unroll") for (int n = 0; n < 2; ++n) _Pragma("unroll") for (int k = 0; k < 2; ++k) \
        acc[ai][bj][m][n] = __builtin_amdgcn_mfma_f32_16x16x32_bf16(Bt[n][k], At[m][k], acc[ai][bj][m][n], 0, 0, 0); __builtin_amdgcn_s_setprio(0); } while (0)
#define PG8_WAIT_V(n) asm volatile("s_waitcnt vmcnt(" #n ")" ::: "memory")
#define PG8_WAIT_L(n) asm volatile("s_waitcnt lgkmcnt(" #n ")" ::: "memory")
#define PG8_BAR __builtin_amdgcn_s_barrier()
#define PG8_SCHED __builtin_amdgcn_sched_barrier(0)
    Unit cur, nxt; int ui = 0;
    if (!S.next(0, cur)) return;
    f32x4 acc[2][2][4][2];
#pragma unroll
    for (int a = 0; a < 2; ++a)
#pragma unroll
        for (int b = 0; b < 2; ++b)
#pragma unroll
            for (int m = 0; m < 4; ++m)
#pragma unroll
                for (int n = 0; n < 2; ++n) acc[a][b][m][n] = (f32x4){0.f, 0.f, 0.f, 0.f};
    bf16x8 At[4][2], B0[2][2], B1[2][2];
    const char* cA = cur.A; const char* cB = cur.B;
    unsigned voffA[2]; voffA[0] = cur.za ? vA1[0] : vA0[0]; voffA[1] = cur.za ? vA1[1] : vA0[1];
    size_t hstepA = cur.za ? hsA1 : hsA0;
    PG8_STAGE(PG8_SB(0, 0), cB, voffB); PG8_STAGE(PG8_SB(0, 1), cB + hstepB, voffB); PG8_STAGE(PG8_SA(0, 0), cA, voffA); PG8_STAGE(PG8_SA(0, 1), cA + hstepA, voffA);
    if (wr == 1) PG8_BAR;
    PG8_WAIT_V(2); PG8_BAR;
    PG8_STAGE(PG8_SB(1, 0), cB + kstep, voffB); PG8_STAGE(PG8_SA(1, 0), cA + kstep, voffA); PG8_STAGE(PG8_SB(1, 1), cB + hstepB + kstep, voffB);
    PG8_WAIT_V(6); PG8_BAR;
    for (;;) {
        const bool has_next = S.next(ui + 1, nxt);
        const char* nA = has_next ? nxt.A : cA; const char* nB = has_next ? nxt.B : cB;
        const int nt = cur.nt;
        const bool nza = has_next ? (nxt.za != 0) : (cur.za != 0);
        for (int t = 0; t < nt; t += 2) {
            const bool last = (t == nt - 2);
            unsigned voffN[2]; voffN[0] = last ? (nza ? vA1[0] : vA0[0]) : voffA[0]; voffN[1] = last ? (nza ? vA1[1] : vA0[1]) : voffA[1];
            const size_t hstepN = last ? (nza ? hsA1 : hsA0) : hstepA;
            const char* a1 = cA + (size_t)(t + 1) * kstep;
            const char* a2 = last ? nA : cA + (size_t)(t + 2) * kstep; const char* b2 = last ? nB : cB + (size_t)(t + 2) * kstep;
            const char* a3 = a2 + kstep; const char* b3 = b2 + kstep;
            PG8_LDB(B0, 0, 0); PG8_LDB(B1, 0, 1); PG8_SCHED; PG8_LDA(At, 0, 0); PG8_STAGE(PG8_SA(1, 1), a1 + hstepA, voffA);
            PG8_WAIT_V(8); PG8_WAIT_L(0); PG8_BAR; PG8_MMA(0, 0, At, B0); PG8_MMA(0, 1, At, B1); PG8_BAR; PG8_SCHED;
            PG8_LDA(At, 0, 1); PG8_STAGE(PG8_SB(0, 0), b2, voffB); PG8_STAGE(PG8_SB(0, 1), b2 + hstepB, voffB); PG8_STAGE(PG8_SA(0, 0), a2, voffN);
            PG8_WAIT_V(8); PG8_WAIT_L(0); PG8_BAR; PG8_MMA(1, 0, At, B0); PG8_MMA(1, 1, At, B1); PG8_BAR; PG8_SCHED;
            PG8_LDB(B0, 1, 0); PG8_LDB(B1, 1, 1); PG8_SCHED; PG8_LDA(At, 1, 0); PG8_STAGE(PG8_SA(0, 1), a2 + hstepN, voffN);
            PG8_WAIT_V(8); PG8_WAIT_L(0); PG8_BAR; PG8_MMA(0, 0, At, B0); PG8_MMA(0, 1, At, B1); PG8_BAR; PG8_SCHED;
            PG8_LDA(At, 1, 1); PG8_STAGE(PG8_SB(1, 0), b3, voffB); PG8_STAGE(PG8_SB(1, 1), b3 + hstepB, voffB); PG8_STAGE(PG8_SA(1, 0), a3, voffN);
            PG8_WAIT_V(8); PG8_WAIT_L(0); PG8_BAR; PG8_MMA(1, 0, At, B0); PG8_MMA(1, 1, At, B1); PG8_BAR; PG8_SCHED;
        }
        if (wr == 0) PG8_BAR;
        E(acc, cur, wr, wc, fr, fq);
        if (!has_next) break;
#pragma unroll
        for (int a = 0; a < 2; ++a)
#pragma unroll
            for (int b = 0; b < 2; ++b)
#pragma unroll
                for (int m = 0; m < 4; ++m)
#pragma unroll
                    for (int n = 0; n < 2; ++n) acc[a][b][m][n] = (f32x4){0.f, 0.f, 0.f, 0.f};
        cur = nxt; cA = nA; cB = nB; ++ui;
        voffA[0] = cur.za ? vA1[0] : vA0[0]; voffA[1] = cur.za ? vA1[1] : vA0[1]; hstepA = cur.za ? hsA1 : hsA0;
        if (wr == 1) PG8_BAR;
    }
    PG8_WAIT_V(0);
    PG8_BAR;
#undef PG8_SA
#undef PG8_SB
#undef PG8_STAGE
#undef PG8_LDA
#undef PG8_LDB
#undef PG8_MMA
#undef PG8_WAIT_V
#undef PG8_WAIT_L
#undef PG8_BAR
#undef PG8_SCHED
}
}

struct SchedG1 {
    const char* A; const char* B; int G, c;
    DI bool next(int i, pgx::Unit& u) const {
        int pm, pn; if (!pgx::static_tile(i, G, c, MP / 256, ZP / 256, pm, pn)) return false;
        u.pm = pm; u.pn = pn; u.seg = 0; u.za = 0; u.nt = DM / 64; u.A = A + (size_t)pm * 256 * DM * 2; u.B = B + (size_t)pn * 256 * DM * 2; return true;
    }
};
struct EpiG1 {
    static constexpr bool PERM = true;
    bf16* Z; float* out;
    DI void operator()(const f32x4 (&acc)[2][2][4][2], const pgx::Unit& u, int wr, int wc, int fr, int fq) const {
        const int colt = u.pn * 256;
        const bool act = (colt < ZC_FA) || (colt >= ZC_GA && colt < ZC_XB) || (colt >= ZC_GB && colt < ZC_QC) || (colt >= ZC_GC);
        const float sc = (colt >= ZC_QC && colt < ZC_GC) ? QSCALE : 1.0f;
        const bool convt = (colt >= ZC_XB && colt < ZC_GB) && ((u.pm & 7) == 7);
        const int row0 = u.pm * 256 + wr * 64 + fr, col0 = colt + wc * 32 + 8 * fq;
#pragma unroll
        for (int ai = 0; ai < 2; ++ai)
#pragma unroll
            for (int m = 0; m < 4; ++m) { const int row = row0 + ai * 128 + m * 16; bf16* rowp = Z + (size_t)row * ZP + col0;
#pragma unroll
                for (int bj = 0; bj < 2; ++bj) { f32x4 v0 = acc[ai][bj][m][0], v1 = acc[ai][bj][m][1];
                    if (convt) { const int t3 = (row & 2047) - 2045; if (t3 >= 0) { float* o = out + O_CP + (size_t)((row >> 11) * 3 + t3) * 1024 + (col0 + bj * 128 - ZC_XB); *(f32x4*)o = v0; *(f32x4*)(o + 4) = v1; } }
                    if (act) { v0.x = silu(v0.x); v0.y = silu(v0.y); v0.z = silu(v0.z); v0.w = silu(v0.w); v1.x = silu(v1.x); v1.y = silu(v1.y); v1.z = silu(v1.z); v1.w = silu(v1.w); }
                    v0 = v0 * sc; v1 = v1 * sc;
                    u32x4 w; w.x = pk2(v0.x, v0.y); w.y = pk2(v0.z, v0.w); w.z = pk2(v1.x, v1.y); w.w = pk2(v1.z, v1.w);
                    *(u32x4*)(rowp + bj * 128) = w; } }
    }
};

DI void phase_g1(Ctx& c) {
    { SchedG1 S{(const char*)WSP(bf16, WS_H), (const char*)WSP(bf16, WS_WIN), c.G, c.bid}; EpiG1 E{WSP(bf16, WS_Z), c.out};
      pgx::gemm_phase(c.lds, DM, DM, DM, S, E); }
    constexpr int T_Z = (MS / 128) * (ZP / 128), T_K = 16 * 4, T_V = 4 * 16;
    for (int it = c.bid; it < T_Z + T_K + T_V; it += c.G) {
        if (it < T_Z) { const int tm = it / (ZP / 128), tn = it % (ZP / 128);
            gemm_tile(c, WSP(bf16, WS_H), DM, WSP(bf16, WS_WIN), DM, DM, MP + tm * 128, tn * 128, EpiZ{WSP(bf16, WS_Z), c.out}); }
        else if (it < T_Z + T_K) { const int i = it - T_Z, tm = i >> 2, tn = i & 3;
            gemm_tile(c, WSP(bf16, WS_HM), DM, WSP(bf16, WS_WMEM), DM, DM, tm * 128, tn * 128, EpiMK{WSP(bf16, WS_KBP), c.out}); }
        else { const int i = it - T_Z - T_K, tm = i >> 4, tn = i & 15;
            gemm_tile(c, WSP(bf16, WS_WMEM) + (size_t)512 * DM, DM, WSP(bf16, WS_HM), DM, DM, tm * 128, tn * 128, EpiMV{WSP(bf16, WS_VTP), c.out}); }
    }
}

struct SchedG3 {
    const char* ws; int G, c;
    DI bool next(int i, pgx::Unit& u) const {
        const int r = i / 6, sg = i - 6 * r; int pm, pn; if (!pgx::static_tile(r, G, c, MP / 256, 4, pm, pn)) return false;
        const int br = sg >> 1; u.pm = pm; u.pn = pn; u.seg = sg;
        static_assert(WS_WB == WS_WA + 2 * MiB && WS_WC == WS_WA + 4 * MiB && ZC_GB == 2 * ZC_GA && ZC_GC == 3 * ZC_GA, "branch strides");
        if ((sg & 1) == 0) { u.za = 0; u.nt = 16; u.A = ws + WS_H + (size_t)pm * 256 * DM * 2; u.B = ws + WS_WIN + (size_t)(5120 + 1024 * br + 256 * pn) * DM * 2; }
        else { u.za = 1; u.nt = (br == 1) ? 16 : 8;
            u.A = ws + WS_Z + ((size_t)pm * 256 * ZP + (size_t)ZC_GA * (br + 1)) * 2; u.B = ws + WS_WA + (size_t)br * 2 * MiB + (size_t)(256 * pn) * DM * 2; }
        return true;
    }
};
struct EpiG3 {
    static constexpr bool PERM = true;
    bf16* Z;
    DI void operator()(const f32x4 (&acc)[2][2][4][2], const pgx::Unit& u, int wr, int wc, int fr, int fq) const {
        const int row0 = u.pm * 256 + wr * 64 + fr, col0 = u.pn * 256 + wc * 32 + 8 * fq, sg = u.seg;
#pragma unroll
        for (int ai = 0; ai < 2; ++ai)
#pragma unroll
            for (int m = 0; m < 4; ++m) { bf16* rowp = Z + (size_t)(row0 + ai * 128 + m * 16) * ZP;
#pragma unroll
                for (int bj = 0; bj < 2; ++bj) { const int col = col0 + bj * 128; const int mcol = (col < 512) ? 1024 + col : 1536 + col;
                    const f32x4 v0 = acc[ai][bj][m][0], v1 = acc[ai][bj][m][1];
                    u32x4 w;
                    if ((sg & 1) == 0) { w.x = pk2(sigm(v0.x), sigm(v0.y)); w.y = pk2(sigm(v0.z), sigm(v0.w)); w.z = pk2(sigm(v1.x), sigm(v1.y)); w.w = pk2(sigm(v1.z), sigm(v1.w)); *(u32x4*)(rowp + col) = w; }
                    else {
                        float g[8], mo[8]; unpack8(*(const u32x4*)(rowp + col), g);
                        { u32x4 mw = *(const u32x4*)(rowp + mcol); if (sg == 1) mw = (u32x4){0u, 0u, 0u, 0u}; unpack8(mw, mo); }
                        w.x = pk2(mo[0] + g[0] * v0.x, mo[1] + g[1] * v0.y); w.y = pk2(mo[2] + g[2] * v0.z, mo[3] + g[3] * v0.w);
                        w.z = pk2(mo[4] + g[4] * v1.x, mo[5] + g[5] * v1.y); w.w = pk2(mo[6] + g[6] * v1.z, mo[7] + g[7] * v1.w);
                        *(u32x4*)(rowp + (sg == 5 ? col : mcol)) = w;
                    } }
                asm volatile("" ::: "memory"); }
    }
};
struct SchedG4 {
    const char* Zb; const char* WO; int G, c;
    DI bool next(int i, pgx::Unit& u) const {
        int pm, pn; if (!pgx::static_tile(i, G, c, MP / 256, 4, pm, pn)) return false;
        u.pm = pm; u.pn = pn; u.seg = 0; u.za = 1; u.nt = 16; u.A = Zb + ((size_t)pm * 256 * ZP + ZC_MG) * 2; u.B = WO + (size_t)(256 * pn) * DM * 2; return true;
    }
};
struct EpiG4 {
    static constexpr bool PERM = false;
    const float* x; float* out;
    DI void operator()(const f32x4 (&acc)[2][2][4][2], const pgx::Unit& u, int wr, int wc, int fr, int fq) const {
        const int row0 = u.pm * 256 + wr * 64 + fr, col0 = u.pn * 256 + wc * 32 + 4 * fq;
#pragma unroll
        for (int ai = 0; ai < 2; ++ai)
#pragma unroll
            for (int m = 0; m < 4; ++m) { const size_t off = (size_t)(row0 + ai * 128 + m * 16) * DM + col0;
#pragma unroll
                for (int bj = 0; bj < 2; ++bj)
#pragma unroll
                    for (int n = 0; n < 2; ++n) { const f32x4 xv = *(const f32x4*)(x + off + bj * 128 + n * 16); *(f32x4*)(out + off + bj * 128 + n * 16) = xv + acc[ai][bj][m][n]; } }
    }
};

DI void phase_g3(Ctx& c) {
    { SchedG3 S{(const char*)c.ws, c.G, c.bid};
      EpiG3 E{WSP(bf16, WS_Z)}; pgx::gemm_phase(c.lds, DM, ZP, DM, S, E); }
    constexpr int NT = (MS / 128) * 8;
    const bf16* Z = WSP(bf16, WS_Z);
    for (int it = c.bid; it < NT; it += c.G) {
        const int m0 = MP + (it >> 3) * 128, n0 = (it & 7) * 128;
        f32x16 M[2], P[2], Gt[2];
#pragma unroll
        for (int j = 0; j < 2; ++j)
#pragma unroll
            for (int i = 0; i < 16; ++i) M[j][i] = 0.f;
#pragma unroll 1
        for (int br = 0; br < 3; ++br) {
#pragma unroll
            for (int j = 0; j < 2; ++j)
#pragma unroll
                for (int i = 0; i < 16; ++i) P[j][i] = 0.f;
            gemm_kloop(c, P, WSP(bf16, WS_H), DM, WSP(bf16, WS_WIN) + (size_t)(5120 + 1024 * br) * DM, DM, DM, m0, n0);
#pragma unroll
            for (int j = 0; j < 2; ++j)
#pragma unroll
                for (int i = 0; i < 16; ++i) { Gt[j][i] = sigm(P[j][i]); P[j][i] = 0.f; }
            const bf16* Y = Z + (br == 0 ? ZC_GA : br == 1 ? ZC_GB : ZC_GC);
            const bf16* W = br == 0 ? WSP(bf16, WS_WA) : br == 1 ? WSP(bf16, WS_WB) : WSP(bf16, WS_WC);
            const int Kb = br == 1 ? 1024 : 512;
            gemm_kloop(c, P, Y, ZP, W, DM, Kb, m0, n0);
#pragma unroll
            for (int j = 0; j < 2; ++j)
#pragma unroll
                for (int i = 0; i < 16; ++i) M[j][i] += Gt[j][i] * P[j][i];
        }
        gemm_epi(c, M, m0, n0, EpiMG{WSP(bf16, WS_Z)});
    }
}
DI void phase_g4(Ctx& c) {
    { SchedG4 S{(const char*)WSP(bf16, WS_Z), (const char*)WSP(bf16, WS_WOUT), c.G, c.bid}; EpiG4 E{c.in[0], c.out}; pgx::gemm_phase(c.lds, DM, ZP, DM, S, E); }
    constexpr int NT = (MS / 128) * 8;
    for (int it = c.bid; it < NT; it += c.G) {
        const int m0 = MP + (it >> 3) * 128, n0 = (it & 7) * 128;
        gemm_tile(c, WSP(bf16, WS_Z) + ZC_MG, ZP, WSP(bf16, WS_WOUT), DM, DM, m0, n0, EpiY{c.in[0], c.in[1], c.out});
    }
}
DI void phase_final(Ctx& c) {
    const int gw = c.bid * 8 + c.wave, NGW = c.G * 8;
    for (int m = gw; m < MT; m += NGW) {
        f32x4* xr = (f32x4*)(c.out + (size_t)m * DM) + c.lane; const f32x4* gr = (const f32x4*)c.in[26] + c.lane;
        f32x4 v[4]; float s = 0.f;
#pragma unroll
        for (int j = 0; j < 4; ++j) { v[j] = xr[64 * j]; s += (v[j].x * v[j].x + v[j].y * v[j].y) + (v[j].z * v[j].z + v[j].w * v[j].w); }
        const float rs = 1.0f / sqrtf(wave_sum(s) * (1.f / DM) + EPS);
#pragma unroll
        for (int j = 0; j < 4; ++j) { const f32x4 gg = gr[64 * j]; xr[64 * j] = v[j] * rs * gg; }
    }
}

constexpr int A_BL = 0, A_SEG = 32768, A_BLAST = 34816, A_SS = 35328, A_QG = 36864, A_KG = 53248, A_ATT = 69632, A_VT = 77824, A_KPT = 94208;
DI int swz256(int row, int chunk) { return row * 256 + ((chunk ^ (row & 15)) << 4); }
template <int MODE>
DI void hgrn_item(Ctx& c, int mrow0, int valid, int h, const bf16* STin, bf16* STout, float* DCout, const float* s0, float* snew) {
    const int tid = c.tid, lane = c.lane, w = c.wave, r = lane & 31, hh = lane >> 5;
    bf16* Z = WSP(bf16, WS_Z);
    LAS unsigned char* L = c.lds;
    LAS float* BL = (LAS float*)(L + A_BL); LAS float* SEG = (LAS float*)(L + A_SEG); LAS float* BLAST = (LAS float*)(L + A_BLAST); LAS float* SS = (LAS float*)(L + A_SS);
    const float* lbl = c.in[10];
    const int t = tid >> 3, k16 = (tid & 7) * 16;
    const bool tv = t < valid;
#pragma unroll 1
    for (int half = 0; half < 2; ++half) {
        const int k8 = k16 + 8 * half;
        float fa[8], vv[8];
        if (tv) { const bf16* zr = Z + (size_t)(mrow0 + t) * ZP + h * 128 + k8;
            unpack8(*(const u32x4*)(zr + ZC_FA), fa); unpack8(*(const u32x4*)(zr + ZC_VA), vv);
        } else {
#pragma unroll
            for (int i = 0; i < 8; ++i) { fa[i] = 0.f; vv[i] = 0.f; }
        }
#pragma unroll
        for (int i = 0; i < 8; ++i) {
            const int k = h * 128 + k8 + i;
            const float lb = 1.0f / (1.0f + __expf(lbl[512 + k] - lbl[k]));
            const float f = lb + (1.0f - lb) * sigm(fa[i]);
            BL[t * 128 + k8 + i] = tv ? __logf(f) : 0.f;
            const int v = k8 + i;
            *(LAS unsigned short*)(L + A_VT + swz128(v, t >> 3) + (t & 7) * 2) = (unsigned short)(pk2(vv[i], 0.f) & 0xffffu);
        }
    }
    __syncthreads();
    {
        const int k = tid & 127, seg = tid >> 7; float run = 0.f;
#pragma unroll
        for (int i = 0; i < 16; ++i) { run += BL[(16 * seg + i) * 128 + k]; BL[(16 * seg + i) * 128 + k] = run; }
        SEG[seg * 128 + k] = run;
        __syncthreads();
        float off = 0.f;
#pragma unroll
        for (int s = 0; s < 3; ++s) if (s < seg) off += SEG[s * 128 + k];
        if (seg > 0) {
#pragma unroll
            for (int i = 0; i < 16; ++i) BL[(16 * seg + i) * 128 + k] += off;
        }
        if (seg == 3) BLAST[k] = off + run;
        __syncthreads();
    }
#pragma unroll 1
    for (int half = 0; half < 2; ++half) {
        const int k8 = k16 + 8 * half;
        float bb[8], omf[8];
#pragma unroll
        for (int i = 0; i < 8; ++i) bb[i] = BL[t * 128 + k8 + i];
        {
            float fa[8];
            if (tv) unpack8(*(const u32x4*)(Z + (size_t)(mrow0 + t) * ZP + ZC_FA + h * 128 + k8), fa);
            else {
#pragma unroll
                for (int i = 0; i < 8; ++i) fa[i] = 0.f;
            }
#pragma unroll
            for (int i = 0; i < 8; ++i) { const int k = h * 128 + k8 + i; const float lb = 1.0f / (1.0f + __expf(lbl[512 + k] - lbl[k])); omf[i] = tv ? (1.0f - lb) * (1.0f - sigm(fa[i])) : 0.f; }
        }
        if (MODE & 2) {
            float q[8];
            if (tv) unpack8(*(const u32x4*)(Z + (size_t)(mrow0 + t) * ZP + ZC_QA + h * 128 + k8), q);
            else {
#pragma unroll
                for (int i = 0; i < 8; ++i) q[i] = 0.f;
            }
            float qg[8], kg[8];
#pragma unroll
            for (int i = 0; i < 8; ++i) { qg[i] = q[i] * __expf(bb[i]); kg[i] = omf[i] * __expf(-bb[i]); }
            u32x4 oq, ok;
            oq.x = pk2(qg[0], qg[1]); oq.y = pk2(qg[2], qg[3]); oq.z = pk2(qg[4], qg[5]); oq.w = pk2(qg[6], qg[7]);
            ok.x = pk2(kg[0], kg[1]); ok.y = pk2(kg[2], kg[3]); ok.z = pk2(kg[4], kg[5]); ok.w = pk2(kg[6], kg[7]);
            *(LAS u32x4*)(L + A_QG + swz256(t, k8 >> 3)) = oq;
            *(LAS u32x4*)(L + A_KG + swz256(t, k8 >> 3)) = ok;
        }
        if (MODE & 1) {
#pragma unroll
            for (int i = 0; i < 8; ++i) { const int k = k8 + i; const float kp = omf[i] * __expf(BLAST[k] - bb[i]);
                *(LAS unsigned short*)(L + A_KPT + swz128(k, t >> 3) + (t & 7) * 2) = (unsigned short)(pk2(kp, 0.f) & 0xffffu); }
        }
    }
    __syncthreads();
    if (MODE & 1) {
        const int kt = w & 3, vp = w >> 2;
        f32x16 acc[2];
#pragma unroll
        for (int j = 0; j < 2; ++j)
#pragma unroll
            for (int i = 0; i < 16; ++i) acc[j][i] = 0.f;
#pragma unroll
        for (int s = 0; s < 4; ++s) {
            const bf16x8 a = *(const LAS bf16x8*)(L + A_KPT + swz128(32 * kt + r, 2 * s + hh));
#pragma unroll
            for (int j = 0; j < 2; ++j) { const bf16x8 b = *(const LAS bf16x8*)(L + A_VT + swz128(32 * (2 * vp + j) + r, 2 * s + hh)); acc[j] = MFMA32(a, b, acc[j]); }
        }
        if (MODE == 1) {
#pragma unroll
            for (int j = 0; j < 2; ++j) { const int v = 32 * (2 * vp + j) + r;
#pragma unroll
                for (int g = 0; g < 4; ++g) { const int k = 32 * kt + 8 * g + 4 * hh; u32x2 o; o.x = pk2(acc[j][4 * g], acc[j][4 * g + 1]); o.y = pk2(acc[j][4 * g + 2], acc[j][4 * g + 3]);
                    *(u32x2*)(STout + v * 128 + k) = o; } }
            if (tid < 128) DCout[tid] = __expf(BLAST[tid]);
        } else {
#pragma unroll
            for (int j = 0; j < 2; ++j) { const int v = 32 * (2 * vp + j) + r;
#pragma unroll
                for (int g = 0; g < 4; ++g) {
#pragma unroll
                    for (int i = 4 * g; i < 4 * g + 4; ++i) { const int k = 32 * kt + crow(i, hh); snew[k * 128 + v] = __expf(BLAST[k]) * s0[k * 128 + v] + acc[j][i]; }
                    asm volatile("" ::: "memory"); } }
        }
    }
    if (MODE & 2) {
        if (w < 4) {
            const int si = w >> 1, tj = w & 1;
            f32x16 acc;
#pragma unroll
            for (int i = 0; i < 16; ++i) acc[i] = 0.f;
            if (si <= tj) {
#pragma unroll
                for (int s = 0; s < 8; ++s) { const bf16x8 a = *(const LAS bf16x8*)(L + A_KG + swz256(32 * si + r, 2 * s + hh)); const bf16x8 b = *(const LAS bf16x8*)(L + A_QG + swz256(32 * tj + r, 2 * s + hh)); acc = MFMA32(a, b, acc); }
            }
            const int tt = 32 * tj + r;
#pragma unroll
            for (int g = 0; g < 4; ++g) { const int s0_ = 32 * si + 8 * g + 4 * hh; float v[4];
#pragma unroll
                for (int i = 0; i < 4; ++i) v[i] = (s0_ + i <= tt) ? acc[4 * g + i] : 0.f;
                u32x2 o; o.x = pk2(v[0], v[1]); o.y = pk2(v[2], v[3]);
                *(LAS u32x2*)(L + A_ATT + swz128(tt, s0_ >> 3) + (s0_ & 7) * 2) = o; }
        }
        __syncthreads();
        const int vt = w & 3, tj = w >> 2;
        f32x16 acc;
#pragma unroll
        for (int i = 0; i < 16; ++i) acc[i] = 0.f;
#pragma unroll
        for (int s = 0; s < 4; ++s) { const bf16x8 a = *(const LAS bf16x8*)(L + A_VT + swz128(32 * vt + r, 2 * s + hh)); const bf16x8 b = *(const LAS bf16x8*)(L + A_ATT + swz128(32 * tj + r, 2 * s + hh)); acc = MFMA32(a, b, acc); }
        { const bf16* sp = STin + (32 * vt + r) * 128 + 8 * hh;
#pragma unroll
          for (int s = 0; s < 8; ++s) { const bf16x8 a = *(const bf16x8*)(sp + 16 * s); const bf16x8 b = *(const LAS bf16x8*)(L + A_QG + swz256(32 * tj + r, 2 * s + hh)); acc = MFMA32(a, b, acc); } }
        float ssq = 0.f;
#pragma unroll
        for (int i = 0; i < 16; ++i) ssq += acc[i] * acc[i];
        ssq += __shfl_xor(ssq, 32);
        const int tt = 32 * tj + r;
        if (hh == 0) SS[vt * 64 + tt] = ssq;
        __syncthreads();
        const float tot = (SS[tt] + SS[64 + tt]) + (SS[128 + tt] + SS[192 + tt]);
        const float rs = 1.0f / sqrtf(tot * (1.0f / 128.0f) + EPS);
        if (tt < valid) {
            const float* ga = c.in[11] + h * 128;
#pragma unroll
            for (int g = 0; g < 4; ++g) { const int v0 = 32 * vt + 8 * g + 4 * hh; bf16* zp = Z + (size_t)(mrow0 + tt) * ZP + ZC_GA + h * 128 + v0;
                float gg[4]; unpack4(*(const u32x2*)zp, gg); const f32x4 gw = *(const f32x4*)(ga + v0);
                u32x2 o; o.x = pk2(acc[4 * g] * rs * gw.x * gg[0], acc[4 * g + 1] * rs * gw.y * gg[1]); o.y = pk2(acc[4 * g + 2] * rs * gw.z * gg[2], acc[4 * g + 3] * rs * gw.w * gg[3]);
                *(u32x2*)zp = o; }
        }
    }
    __syncthreads();
}

constexpr int B_XCF = 0, B_XCB = 16384, B_RG = 24576, B_IG = 40960, B_AGG = 57344;
template <int MODE>
DI void lru_item(Ctx& c, int b, int j, int n) {
    const int tid = c.tid, lane = c.lane, w = c.wave, r = lane & 31, hh = lane >> 5;
    bf16* Z = WSP(bf16, WS_Z);
    LAS unsigned char* L = c.lds;
    LAS float* XCF = (LAS float*)(L + B_XCF); LAS float* RG = (LAS float*)(L + B_RG); LAS float* IG = (LAS float*)(L + B_IG); LAS float* AGG = (LAS float*)(L + B_AGG);
    const int valid = (MODE == 2) ? 32 : 64;
    const int rowbase = (MODE == 2) ? MP + b * DSEQ : b * SEQ + 64 * j;
    {
        const int t = tid >> 3, c8 = (tid & 7) * 8, ch = n * 64 + c8;
        float xc[8];
        const f32x4 bc0 = *(const f32x4*)(c.in[14] + ch), bc1 = *(const f32x4*)(c.in[14] + ch + 4);
        xc[0] = bc0.x; xc[1] = bc0.y; xc[2] = bc0.z; xc[3] = bc0.w; xc[4] = bc1.x; xc[5] = bc1.y; xc[6] = bc1.z; xc[7] = bc1.w;
#pragma unroll
        for (int jj = 0; jj < 4; ++jj) {
            float x[8];
            const int T = ((MODE == 2) ? 0 : 64 * j) + t + jj - 3;
            if (T >= 0) { unpack8(*(const u32x4*)(Z + (size_t)(rowbase + t + jj - 3) * ZP + ZC_XB + ch), x); }
            else if (MODE == 2) { const float* sc = c.in[6] + (size_t)(b * 3 + (T + 3)) * 1024 + ch; const f32x4 a0 = *(const f32x4*)sc, a1 = *(const f32x4*)(sc + 4);
                x[0] = a0.x; x[1] = a0.y; x[2] = a0.z; x[3] = a0.w; x[4] = a1.x; x[5] = a1.y; x[6] = a1.z; x[7] = a1.w; }
            else {
#pragma unroll
                for (int i = 0; i < 8; ++i) x[i] = 0.f;
            }
            const f32x4 w0 = *(const f32x4*)(c.in[13] + jj * 1024 + ch), w1 = *(const f32x4*)(c.in[13] + jj * 1024 + ch + 4);
            xc[0] += w0.x * x[0]; xc[1] += w0.y * x[1]; xc[2] += w0.z * x[2]; xc[3] += w0.w * x[3]; xc[4] += w1.x * x[4]; xc[5] += w1.y * x[5]; xc[6] += w1.z * x[6]; xc[7] += w1.w * x[7];
        }
        if (t >= valid) {
#pragma unroll
            for (int i = 0; i < 8; ++i) xc[i] = 0.f;
        }
        *(LAS f32x4*)(XCF + t * 64 + c8) = (f32x4){xc[0], xc[1], xc[2], xc[3]}; *(LAS f32x4*)(XCF + t * 64 + c8 + 4) = (f32x4){xc[4], xc[5], xc[6], xc[7]};
        u32x4 o; o.x = pk2(xc[0], xc[1]); o.y = pk2(xc[2], xc[3]); o.z = pk2(xc[4], xc[5]); o.w = pk2(xc[6], xc[7]);
        *(LAS u32x4*)(L + B_XCB + swz128(t, c8 >> 3)) = o;
    }
    __syncthreads();
    {
        const int gate = w >> 2, tt = (w >> 1) & 1, ee = w & 1;
        const bf16* Wt = WSP(bf16, WS_WLRU) + gate * 65536 + (size_t)n * 4096 + (32 * ee + r) * 64 + 8 * hh;
        f32x16 acc;
#pragma unroll
        for (int i = 0; i < 16; ++i) acc[i] = 0.f;
#pragma unroll
        for (int s = 0; s < 4; ++s) { const bf16x8 a = *(const LAS bf16x8*)(L + B_XCB + swz128(32 * tt + r, 2 * s + hh)); const bf16x8 bq = *(const bf16x8*)(Wt + 16 * s); acc = MFMA32(a, bq, acc); }
        const int e = 32 * ee + r; const float bias = (gate ? c.in[18] : c.in[16])[n * 64 + e];
        LAS float* dst = gate ? IG : RG;
#pragma unroll
        for (int i = 0; i < 16; ++i) dst[(32 * tt + crow(i, hh)) * 64 + e] = sigm(acc[i] + bias);
    }
    __syncthreads();
    {
        const int ch = n * 64 + lane;
        const float sp = log1pf(__expf(-c.in[19][ch]));
        float pc[8], hl[8]; float pr = 1.f, hloc = 0.f;
#pragma unroll
        for (int tk = 0; tk < 8; ++tk) {
            const int t = 8 * w + tk;
            const float rg = RG[t * 64 + lane], ig = IG[t * 64 + lane], xc = XCF[t * 64 + lane];
            const float la = -8.0f * rg * sp;
            const float a = __expf(la);
            float mult = sqrtf(-expm1f(2.0f * la));
            if (MODE != 2 && j == 0 && t == 0) mult = 1.0f;
            const float u = mult * ig * xc;
            hloc = a * hloc + u; pr = pr * a; pc[tk] = pr; hl[tk] = hloc;
        }
        AGG[(w * 64 + lane) * 2] = pr; AGG[(w * 64 + lane) * 2 + 1] = hloc;
        __syncthreads();
        float carry = (MODE == 0) ? 0.f : (MODE == 1) ? WSP(float, WS_CIN)[(size_t)(b * 32 + j) * 1024 + ch] : c.in[7][b * 1024 + ch];
        float ptot = 1.f;
#pragma unroll
        for (int ww = 0; ww < 8; ++ww) if (ww < w) { const float p_ = AGG[(ww * 64 + lane) * 2], h_ = AGG[(ww * 64 + lane) * 2 + 1]; carry = p_ * carry + h_; ptot *= p_; }
        if (MODE == 0) {
            if (w == 7) { float* ta = WSP(float, WS_TAGG) + ((size_t)(b * 32 + j) * 1024 + ch) * 2; ta[0] = ptot * pr; ta[1] = hl[7] + pc[7] * carry; }
        } else {
#pragma unroll
            for (int tk = 0; tk < 8; ++tk) {
                const int t = 8 * w + tk;
                if (t < valid) {
                    const float hv = hl[tk] + pc[tk] * carry;
                    bf16* zp = Z + (size_t)(rowbase + t) * ZP + ZC_GB + ch;
                    const float y = hv * bf2f(*zp);
                    *zp = (unsigned short)(pk2(y, 0.f) & 0xffffu);
                    if (MODE == 2 && t == 31) c.out[O_LS + b * 1024 + ch] = hv;
                }
            }
        }
    }
    __syncthreads();
}

DI void attn_wave_item(Ctx& c, int wi) {
    const int lane = c.lane, r = lane & 31, hh = lane >> 5;
    const int rb = wi >> 2, h = wi & 3, m0 = 32 * rb;
    bf16* Z = WSP(bf16, WS_Z);
    const bf16* KB; const bf16* VT;
    if (rb < MP / 32) { const int b = rb >> 6; KB = WSP(bf16, WS_KBP) + (size_t)b * 256 * 512; VT = WSP(bf16, WS_VTP) + (size_t)b * 512 * 256; }
    else { const int b = rb - MP / 32; KB = WSP(bf16, WS_KBS) + (size_t)b * 256 * 512; VT = WSP(bf16, WS_VTS) + (size_t)b * 512 * 256; }
    const bf16* qp = Z + (size_t)(m0 + r) * ZP + ZC_QC + h * 128 + 8 * hh;
    f32x16 O[4];
#pragma unroll
    for (int d = 0; d < 4; ++d)
#pragma unroll
        for (int i = 0; i < 16; ++i) O[d][i] = 0.f;
    float mrun = -INFINITY, l = 0.f;
#pragma unroll 1
    for (int kc = 0; kc < 4; ++kc) {
        f32x16 S[2];
#pragma unroll
        for (int kt = 0; kt < 2; ++kt) {
#pragma unroll
            for (int i = 0; i < 16; ++i) S[kt][i] = 0.f;
            const bf16* kp = KB + (size_t)(64 * kc + 32 * kt + r) * 512 + h * 128 + 8 * hh;
#pragma unroll
            for (int s = 0; s < 8; ++s) { const bf16x8 a = *(const bf16x8*)(kp + 16 * s); const bf16x8 qf = *(const bf16x8*)(qp + 16 * s); S[kt] = MFMA32(a, qf, S[kt]); }
        }
        float mx = S[0][0];
#pragma unroll
        for (int i = 0; i < 16; ++i) { mx = fmaxf(mx, S[0][i]); mx = fmaxf(mx, S[1][i]); }
        mx = fmaxf(mx, __shfl_xor(mx, 32));
        const float mnew = fmaxf(mrun, mx);
        const float alpha = exp2f(mrun - mnew);
        mrun = mnew; l *= alpha;
#pragma unroll
        for (int d = 0; d < 4; ++d)
#pragma unroll
            for (int i = 0; i < 16; ++i) O[d][i] *= alpha;
#pragma unroll
        for (int kt = 0; kt < 2; ++kt)
#pragma unroll
            for (int i = 0; i < 16; ++i) { const float p = exp2f(S[kt][i] - mnew); S[kt][i] = p; l += p; }
#pragma unroll
        for (int kt = 0; kt < 2; ++kt)
#pragma unroll
            for (int s2 = 0; s2 < 2; ++s2) {
                u32x4 pw; pw.x = pk2(S[kt][8 * s2], S[kt][8 * s2 + 1]); pw.y = pk2(S[kt][8 * s2 + 2], S[kt][8 * s2 + 3]); pw.z = pk2(S[kt][8 * s2 + 4], S[kt][8 * s2 + 5]); pw.w = pk2(S[kt][8 * s2 + 6], S[kt][8 * s2 + 7]);
                const bf16x8 pb = __builtin_bit_cast(bf16x8, pw);
                const int key0 = 64 * kc + 32 * kt + 16 * s2 + 4 * hh;
#pragma unroll
                for (int d = 0; d < 4; ++d) { const bf16* vp = VT + (size_t)(h * 128 + 32 * d + r) * 256 + key0; const u32x2 lo = *(const u32x2*)vp, hi = *(const u32x2*)(vp + 8);
                    u32x4 av; av.x = lo.x; av.y = lo.y; av.z = hi.x; av.w = hi.y; O[d] = MFMA32(__builtin_bit_cast(bf16x8, av), pb, O[d]); }
            }
    }
    l += __shfl_xor(l, 32);
    const float inv = 1.0f / l;
#pragma unroll
    for (int d = 0; d < 4; ++d)
#pragma unroll
        for (int g = 0; g < 4; ++g) { const int d0 = 32 * d + 8 * g + 4 * hh; bf16* zp = Z + (size_t)(m0 + r) * ZP + ZC_GC + h * 128 + d0;
            float gg[4]; unpack4(*(const u32x2*)zp, gg);
            u32x2 o; o.x = pk2(O[d][4 * g] * inv * gg[0], O[d][4 * g + 1] * inv * gg[1]); o.y = pk2(O[d][4 * g + 2] * inv * gg[2], O[d][4 * g + 3] * inv * gg[3]);
            *(u32x2*)zp = o; }
}

constexpr int N_A_P = 1024, N_B_P = 4096, N_C = 260, N_A_S = 32, N_B_S = 128;
DI void phase_p2a(Ctx& c) {
    bf16* ST = (bf16*)c.out;
    for (int it = c.bid; it < N_A_P + N_B_P + N_C; it += c.G) {
        if (it < N_A_P) { const int b = it >> 7, cc = (it >> 2) & 31, h = it & 3;
            for (int rr = 0; rr < ((PROBE_REP == 20) ? 2 : 1); ++rr) hgrn_item<1>(c, b * SEQ + 64 * cc, 64, h, nullptr, ST + (size_t)it * 16384, WSP(float, WS_DC) + it * 128, nullptr, nullptr); }
        else if (it < N_A_P + N_B_P) { const int i = it - N_A_P, b = i >> 9, j = (i >> 4) & 31, n = i & 15; for (int rr = 0; rr < ((PROBE_REP == 21) ? 2 : 1); ++rr) lru_item<0>(c, b, j, n); }
        else { const int i = it - N_A_P - N_B_P; attn_wave_item(c, i * 8 + c.wave); }
    }
}
DI void phase_p2b(Ctx& c) {
    bf16* ST = (bf16*)c.out;
    for (int e = c.bid * 512 + c.tid; e < 65536 + 8192; e += c.G * 512) {
        if (e < 65536) {
            const int v = e & 127, kg = (e >> 7) & 15, bh = e >> 11, b = bh >> 2, h = bh & 3;
            float s[8];
#pragma unroll
            for (int i = 0; i < 8; ++i) s[i] = 0.f;
            for (int cc = 0; cc < 32; ++cc) {
                const int item = (b * 32 + cc) * 4 + h;
                u32x4* p = (u32x4*)(ST + (size_t)item * 16384 + v * 128 + kg * 8);
                float kv[8]; unpack8(*p, kv);
                u32x4 o; o.x = pk2(s[0], s[1]); o.y = pk2(s[2], s[3]); o.z = pk2(s[4], s[5]); o.w = pk2(s[6], s[7]); *p = o;
                const float* dc = WSP(float, WS_DC) + item * 128 + kg * 8;
#pragma unroll
                for (int i = 0; i < 8; ++i) s[i] = dc[i] * s[i] + kv[i];
            }
#pragma unroll
            for (int i = 0; i < 8; ++i) c.out[O_HP + ((size_t)bh * 128 + kg * 8 + i) * 128 + v] = s[i];
        } else {
            const int e2 = e - 65536, b = e2 >> 10, ch = e2 & 1023; float carry = 0.f;
            for (int j = 0; j < 32; ++j) { const size_t ix = (size_t)(b * 32 + j) * 1024 + ch; WSP(float, WS_CIN)[ix] = carry; const float* ta = WSP(float, WS_TAGG) + ix * 2; carry = ta[0] * carry + ta[1]; }
            c.out[O_LP + b * 1024 + ch] = carry;
        }
    }
}
DI void phase_p2c(Ctx& c) {
    bf16* ST = (bf16*)c.out;
    for (int it = c.bid; it < N_A_P + N_A_S + N_B_P + N_B_S; it += c.G) {
        if (it < N_A_P) { const int b = it >> 7, cc = (it >> 2) & 31, h = it & 3;
            hgrn_item<2>(c, b * SEQ + 64 * cc, 64, h, ST + (size_t)it * 16384, nullptr, nullptr, nullptr, nullptr); }
        else if (it < N_A_P + N_A_S) { const int i = it - N_A_P, b = i >> 2, h = i & 3;
            hgrn_item<3>(c, MP + b * DSEQ, 32, h, WSP(bf16, WS_ST0) + (size_t)i * 16384, nullptr, nullptr, c.in[5] + (size_t)i * 16384, c.out + O_HS + (size_t)i * 16384); }
        else if (it < N_A_P + N_A_S + N_B_P) { const int i = it - N_A_P - N_A_S, b = i >> 9, j = (i >> 4) & 31, n = i & 15; lru_item<1>(c, b, j, n); }
        else { const int i = it - N_A_P - N_A_S - N_B_P, b = i >> 4, n = i & 15; lru_item<2>(c, b, 0, n); }
    }
}

struct Args { const float* in[27]; float* out; unsigned char* ws; int ph_lo, ph_hi; };
constexpr int N_PHASES = 8;
__global__ void __launch_bounds__(512, 2) mk_fwd(Args a) {
    extern __shared__ __attribute__((aligned(16))) unsigned char lds_raw[];
    Ctx c;
    c.lds = (LAS unsigned char*)lds_raw;
    c.tid = threadIdx.x; c.lane = c.tid & 63; c.wave = __builtin_amdgcn_readfirstlane(c.tid >> 6);
    c.G = gridDim.x; c.bid = blockIdx.x;
#pragma unroll
    for (int i = 0; i < 27; ++i) c.in[i] = a.in[i];
    c.out = a.out; c.ws = a.ws;
    volatile LAS unsigned* MISC = (volatile LAS unsigned*)(c.lds + MISC_OFF);
    if (c.tid < 64) MISC[c.tid] = 0u;
    __syncthreads();
    XcdBarrier bar; bar.bar = (unsigned*)(a.ws + WS_CTL) + 1024; bar.x = 0; bar.st = nullptr;
    if (MK_N_LAUNCHES == 1) bar = xcd_barrier_post((unsigned*)(a.ws + WS_CTL) + 1024, MISC + 8);
    const int lo = a.ph_lo, hi = a.ph_hi;
#define IN(k) (lo <= (k) && (k) < hi)
#define SEAM(k) do { if (IN(k) && IN((k) + 1)) xcd_barrier(bar); } while (0)
#define REPS(k) ((PROBE_REP == (k)) ? 2 : 1)
    if (IN(0)) for (int rr = 0; rr < REPS(0); ++rr) { phase_prologue(c); if (rr + 1 < REPS(0)) xcd_barrier(bar); }
    SEAM(0);
    if (IN(1)) for (int rr = 0; rr < REPS(1); ++rr) { phase_g1(c); if (rr + 1 < REPS(1)) xcd_barrier(bar); }
    SEAM(1);
    if (IN(2)) phase_p2a(c);
    SEAM(2);
    if (IN(3)) phase_p2b(c);
    SEAM(3);
    if (IN(4)) phase_p2c(c);
    SEAM(4);
    if (IN(5)) for (int rr = 0; rr < REPS(5); ++rr) { phase_g3(c); if (rr + 1 < REPS(5)) xcd_barrier(bar); }
    SEAM(5);
    if (IN(6)) for (int rr = 0; rr < REPS(6); ++rr) { phase_g4(c); if (rr + 1 < REPS(6)) xcd_barrier(bar); }
    SEAM(6);
    if (IN(7)) phase_final(c);
#undef IN
#undef SEAM
}

extern "C" void kernel_launch(void* const* d_in, const int* in_sizes, int n_in, void* d_out, int out_size, void* d_ws, size_t ws_size, hipStream_t stream) {
    static int grid = 0;
    if (grid == 0) {
        if (n_in != 27 || ws_size < WS_END) { fprintf(stderr, "kernel_launch: unexpected n_in %d / ws_size %zu (need %zu)\n", n_in, ws_size, (size_t)WS_END); grid = -1; return; }
        int dev = 0, cus = 0, per_cu = 0;
        if (hipGetDevice(&dev) != hipSuccess || hipDeviceGetAttribute(&cus, hipDeviceAttributeMultiprocessorCount, dev) != hipSuccess) { grid = -1; return; }
        if (hipFuncSetAttribute((const void*)mk_fwd, hipFuncAttributeMaxDynamicSharedMemorySize, LDS_BYTES) != hipSuccess) { fprintf(stderr, "kernel_launch: hipFuncSetAttribute failed\n"); grid = -1; return; }
        if (hipOccupancyMaxActiveBlocksPerMultiprocessor(&per_cu, (const void*)mk_fwd, 512, LDS_BYTES) != hipSuccess || per_cu < 1) { fprintf(stderr, "kernel_launch: occupancy query says %d\n", per_cu); per_cu = 1; }
        (void)hipGetLastError();
        grid = cus;
    }
    if (grid < 0) return;
    (void)hipMemsetAsync((char*)d_ws + WS_CTL, 0, CTL_ZERO_BYTES, stream);
    Args a{};
    for (int i = 0; i < 27; ++i) a.in[i] = (const float*)d_in[i];
    a.out = (float*)d_out; a.ws = (unsigned char*)d_ws;
    if (MK_N_LAUNCHES == 1) {
        a.ph_lo = 0; a.ph_hi = N_PHASES;
        hipLaunchKernelGGL(mk_fwd, dim3(grid), dim3(512), LDS_BYTES, stream, a);
    } else {
        for (int p = 0; p < N_PHASES; ++p) { a.ph_lo = p; a.ph_hi = p + 1; hipLaunchKernelGGL(mk_fwd, dim3(grid), dim3(512), LDS_BYTES, stream, a); }
    }
}
```

```cpp
#include <hip/hip_runtime.h>
#include <cstdio>
#include <cstdint>

#ifndef MK_N_LAUNCHES
#define MK_N_LAUNCHES 1
#endif

#define PROBE_REP -1
#define DI __device__ __forceinline__
#define LAS __attribute__((address_space(3)))
typedef unsigned short bf16;
typedef short bf16x8 __attribute__((ext_vector_type(8)));
typedef float f32x16 __attribute__((ext_vector_type(16)));
typedef float f32x4 __attribute__((ext_vector_type(4)));
typedef float f32x2 __attribute__((ext_vector_type(2)));
typedef unsigned u32x4 __attribute__((ext_vector_type(4)));
typedef unsigned u32x2 __attribute__((ext_vector_type(2)));
typedef __bf16 bf16x2_t __attribute__((ext_vector_type(2)));

constexpr int DM = 1024, NB = 8, SEQ = 2048, DSEQ = 32, NMEM = 256;
constexpr int MP = NB * SEQ, MS = NB * DSEQ, MT = MP + MS;
constexpr int ZP = 5120;
constexpr int ZC_QA = 0, ZC_FA = 512, ZC_VA = 1024, ZC_GA = 1536, ZC_XB = 2048, ZC_GB = 3072, ZC_QC = 4096, ZC_GC = 4608;
constexpr int ZC_MG = 0;
constexpr float EPS = 1e-6f;
constexpr float QSCALE = 0.08838834764831845f * 1.4426950408889634f;

constexpr size_t O_YP = 0, O_YS = 16777216, O_HP = 17039360, O_CP = 17563648, O_LP = 17588224, O_MK = 17596416, O_MV = 18644992,
                 O_HS = 19693568, O_CS = 20217856, O_LS = 20242432;

constexpr size_t MiB = 1u << 20;
constexpr size_t WS_CTL = 0, CTL_ZERO_BYTES = 64 * 1024;
constexpr size_t WS_WIN = 1 * MiB, WS_WA = 17 * MiB, WS_WB = 19 * MiB, WS_WC = 21 * MiB, WS_WOUT = 23 * MiB, WS_WMEM = 25 * MiB,
                 WS_WLRU = 27 * MiB, WS_TAGG = 28 * MiB, WS_CIN = 32 * MiB, WS_DC = 34 * MiB, WS_ST0 = 35 * MiB, WS_KBP = 36 * MiB,
                 WS_VTP = 38 * MiB, WS_KBS = 40 * MiB, WS_VTS = 42 * MiB, WS_HM = 44 * MiB, WS_H = 48 * MiB, WS_Z = 81 * MiB;
constexpr size_t WS_END = WS_Z + (size_t)MT * ZP * 2;
static_assert(WS_H + (size_t)MT * DM * 2 <= WS_Z && WS_END <= 256 * MiB, "ws map");

constexpr int LDS_BYTES = 147456;
constexpr int MISC_OFF = 131072;

DI float bf2f(unsigned short b) { return __uint_as_float((unsigned)b << 16); }
DI unsigned pk2(float lo, float hi) { f32x2 v = {lo, hi}; bf16x2_t b = __builtin_convertvector(v, bf16x2_t); return __builtin_bit_cast(unsigned, b); }
DI float frcp(float x) { return __builtin_amdgcn_rcpf(x); }
DI float sigm(float x) { return frcp(1.0f + __expf(-x)); }
DI float silu(float x) { return x * sigm(x); }
DI void unpack8(const u32x4 w, float (&f)[8]) {
    f[0] = __uint_as_float(w.x << 16); f[1] = __uint_as_float(w.x & 0xffff0000u);
    f[2] = __uint_as_float(w.y << 16); f[3] = __uint_as_float(w.y & 0xffff0000u);
    f[4] = __uint_as_float(w.z << 16); f[5] = __uint_as_float(w.z & 0xffff0000u);
    f[6] = __uint_as_float(w.w << 16); f[7] = __uint_as_float(w.w & 0xffff0000u);
}
DI void unpack4(const u32x2 w, float (&f)[4]) {
    f[0] = __uint_as_float(w.x << 16); f[1] = __uint_as_float(w.x & 0xffff0000u);
    f[2] = __uint_as_float(w.y << 16); f[3] = __uint_as_float(w.y & 0xffff0000u);
}
DI int crow(int reg, int h) { return (reg & 3) + 8 * (reg >> 2) + 4 * h; }
#define MFMA32(a, b, c) __builtin_amdgcn_mfma_f32_32x32x16_bf16((a), (b), (c), 0, 0, 0)
DI float wave_sum(float v) {
#pragma unroll
    for (int o = 1; o < 64; o <<= 1) v += __shfl_xor(v, o);
    return v;
}

struct Ctx {
    LAS unsigned char* lds;
    int tid, lane, wave, G, bid;
    const float* in[27];
    float* out;
    unsigned char* ws;
};
#define WSP(T, off) ((T*)(c.ws + (off)))

#define XB_TMO      128
#define XB_XCNT(j)  (256  + 64 * (j))
#define XB_XSUB(j)  (1280 + 64 * (j))
#define XB_XGEN(j)  (2304 + 64 * (j))
#define XB_TOP      3328
#define XB_TOPGEN   3392
#define XCD_BAR_WORDS 3456
#define XB_SPIN_CAP (1u << 18)
DI unsigned xb_ld(unsigned* p)              { return __hip_atomic_load(p, __ATOMIC_RELAXED, __HIP_MEMORY_SCOPE_AGENT); }
DI unsigned xb_add(unsigned* p, unsigned v) { return __hip_atomic_fetch_add(p, v, __ATOMIC_RELAXED, __HIP_MEMORY_SCOPE_AGENT); }
DI unsigned xb_xcc_id() { return (unsigned)__builtin_amdgcn_s_getreg((3 << 11) | 20) & 0xFu; }
#define XB_SPIN(cond, bar) do { unsigned _sp = 0; while (cond) { __builtin_amdgcn_s_sleep(1); \
    if ((++_sp & 255u) == 0u) { if (xb_ld(&(bar)[XB_TMO])) break; if (_sp > XB_SPIN_CAP) { atomicAdd(&(bar)[XB_TMO], 1u); break; } } } } while (0)
struct XcdBarrier { unsigned* bar; unsigned x; volatile LAS unsigned* st; };
DI XcdBarrier xcd_barrier_post(unsigned* bar, volatile LAS unsigned* st) {
    XcdBarrier b; b.bar = bar; b.x = xb_xcc_id(); b.st = st;
    if (threadIdx.x == 0) (void)xb_add(&bar[XB_XCNT(b.x)], 1u);
    return b;
}
DI void xcd_barrier_complete(unsigned* bar, unsigned x, unsigned& nloc, unsigned& nx) {
    const unsigned G = gridDim.x * gridDim.y * gridDim.z;
    unsigned sum, cnt, mine, sp = 0u;
    for (;;) {
        sum = 0u; cnt = 0u; mine = 0u;
#pragma unroll
        for (unsigned j = 0; j < 16; ++j) { const unsigned c = xb_ld(&bar[XB_XCNT(j)]); sum += c; cnt += (c > 0u) ? 1u : 0u; mine = (j == x) ? c : mine; }
        if (sum == G) break;
        __builtin_amdgcn_s_sleep(1);
        if ((++sp & 255u) == 0u) { if (xb_ld(&bar[XB_TMO])) break; if (sp > XB_SPIN_CAP) { atomicAdd(&bar[XB_TMO], 1u); break; } }
    }
    nloc = mine > 0u ? mine : 1u; nx = cnt > 0u ? cnt : 1u;
}
DI void xcd_barrier(const XcdBarrier& b) {
    asm volatile("s_waitcnt vmcnt(0)" ::: "memory");
    __syncthreads();
    if (threadIdx.x == 0) {
        unsigned* bar = b.bar;
        __builtin_amdgcn_s_waitcnt(0);
        unsigned nloc = b.st[0], nx = b.st[1];
        if (nloc == 0u) { xcd_barrier_complete(bar, b.x, nloc, nx); b.st[0] = nloc; b.st[1] = nx; }
        const unsigned old = xb_add(&bar[XB_XSUB(b.x)], 1u);
        const unsigned gen = old / nloc;
        if (old + 1u == (gen + 1u) * nloc) {
            __builtin_amdgcn_fence(__ATOMIC_RELEASE, "agent");
            asm volatile("s_waitcnt vmcnt(0)" ::: "memory");
            const unsigned og = xb_add(&bar[XB_TOP], 1u);
            const unsigned tg = og / nx;
            if (og + 1u == (tg + 1u) * nx) xb_add(&bar[XB_TOPGEN], 1u);
            else XB_SPIN(xb_ld(&bar[XB_TOPGEN]) == tg, bar);
            __builtin_amdgcn_fence(__ATOMIC_ACQUIRE, "agent");
            xb_add(&bar[XB_XGEN(b.x)], 1u);
            asm volatile("s_waitcnt vmcnt(0)" ::: "memory");
        } else {
            XB_SPIN(xb_ld(&bar[XB_XGEN(b.x)]) == gen, bar);
            __builtin_amdgcn_fence(__ATOMIC_ACQUIRE, "agent");
            asm volatile("s_waitcnt vmcnt(0)" ::: "memory");
        }
    }
    __syncthreads();
}

DI void p0_transpose_item(const float* W, int K, int N, bf16* WT, int ldt, int row_off, LAS float* scr, int item, int lane) {
    const int nblk = N / 32, kb = item / nblk, nb = item % nblk, k0 = 64 * kb, n0 = 32 * nb;
#pragma unroll 8
    for (int i = 0; i < 32; ++i) { const int kk = 2 * i + (lane >> 5); scr[kk * 33 + (lane & 31)] = W[(size_t)(k0 + kk) * N + n0 + (lane & 31)]; }
    asm volatile("s_waitcnt lgkmcnt(0)" ::: "memory");
    const int cc = lane & 7;
#pragma unroll
    for (int j = 0; j < 4; ++j) { const int n = (lane >> 3) + 8 * j; const LAS float* s = scr + (8 * cc) * 33 + n;
        u32x4 o; o.x = pk2(s[0 * 33], s[1 * 33]); o.y = pk2(s[2 * 33], s[3 * 33]); o.z = pk2(s[4 * 33], s[5 * 33]); o.w = pk2(s[6 * 33], s[7 * 33]);
        *(u32x4*)(WT + (size_t)(row_off + n0 + n) * ldt + k0 + 8 * cc) = o; }
    asm volatile("s_waitcnt lgkmcnt(0)" ::: "memory");
}
DI void rms_row_to_bf16(const float* xrow, const float* g, bf16* orow, int lane) {
    const f32x4* xr = (const f32x4*)xrow + lane; const f32x4* gr = (const f32x4*)g + lane;
    f32x4 v[4]; float s = 0.f;
#pragma unroll
    for (int j = 0; j < 4; ++j) { v[j] = xr[64 * j]; s += (v[j].x * v[j].x + v[j].y * v[j].y) + (v[j].z * v[j].z + v[j].w * v[j].w); }
    const float rs = __builtin_amdgcn_rsqf(wave_sum(s) * (1.f / DM) + EPS);
    u32x2* o8 = (u32x2*)orow + lane;
#pragma unroll
    for (int j = 0; j < 4; ++j) { const f32x4 gg = gr[64 * j]; u32x2 w; w.x = pk2(v[j].x * rs * gg.x, v[j].y * rs * gg.y); w.y = pk2(v[j].z * rs * gg.z, v[j].w * rs * gg.w); o8[64 * j] = w; }
}
DI void phase_prologue(Ctx& c) {
    LAS float* scr = (LAS float*)(c.lds + c.wave * 16384);
    const int gw = c.bid * 8 + c.wave, NGW = c.G * 8;
    constexpr int I_WIN = 16 * 256, I_WA = 8 * 32, I_WB = 16 * 32, I_WC = 8 * 32, I_WO = 16 * 32, I_MK = 16 * 16, I_MV = 16 * 16, I_LR = 32, I_LI = 32, I_ST = 32 * 8, I_VS = 8 * 64;
    constexpr int NITEMS = I_WIN + I_WA + I_WB + I_WC + I_WO + I_MK + I_MV + I_LR + I_LI + I_ST + I_VS;
    for (int it = gw; it < NITEMS; it += NGW) {
        int r = it;
        if (r < I_WIN) { p0_transpose_item(c.in[9], 1024, 8192, WSP(bf16, WS_WIN), 1024, 0, scr, r, c.lane); continue; } r -= I_WIN;
        if (r < I_WA) { p0_transpose_item(c.in[12], 512, 1024, WSP(bf16, WS_WA), 1024, 0, scr, r, c.lane); continue; } r -= I_WA;
        if (r < I_WB) { p0_transpose_item(c.in[20], 1024, 1024, WSP(bf16, WS_WB), 1024, 0, scr, r, c.lane); continue; } r -= I_WB;
        if (r < I_WC) { p0_transpose_item(c.in[24], 512, 1024, WSP(bf16, WS_WC), 1024, 0, scr, r, c.lane); continue; } r -= I_WC;
        if (r < I_WO) { p0_transpose_item(c.in[25], 1024, 1024, WSP(bf16, WS_WOUT), 1024, 0, scr, r, c.lane); continue; } r -= I_WO;
        if (r < I_MK) { p0_transpose_item(c.in[22], 1024, 512, WSP(bf16, WS_WMEM), 1024, 0, scr, r, c.lane); continue; } r -= I_MK;
        if (r < I_MV) { p0_transpose_item(c.in[23], 1024, 512, WSP(bf16, WS_WMEM), 1024, 512, scr, r, c.lane); continue; } r -= I_MV;
        if (r < I_LR) { const int n = r >> 1; p0_transpose_item(c.in[15] + n * 4096, 64, 64, WSP(bf16, WS_WLRU) + n * 4096, 64, 0, scr, r & 1, c.lane); continue; } r -= I_LR;
        if (r < I_LI) { const int n = r >> 1; p0_transpose_item(c.in[17] + n * 4096, 64, 64, WSP(bf16, WS_WLRU) + 65536 + n * 4096, 64, 0, scr, r & 1, c.lane); continue; } r -= I_LI;
        if (r < I_ST) { const int bh = r >> 3; p0_transpose_item(c.in[5] + (size_t)bh * 16384, 128, 128, WSP(bf16, WS_ST0) + (size_t)bh * 16384, 128, 0, scr, r & 7, c.lane); continue; } r -= I_ST;
        { const int b = r >> 6; p0_transpose_item(c.in[4] + (size_t)b * 131072, 256, 512, WSP(bf16, WS_VTS) + (size_t)b * 131072, 256, 0, scr, r & 63, c.lane); }
    }
    for (int m = gw; m < MT + NB * NMEM; m += NGW) {
        if (m < MP) rms_row_to_bf16(c.in[0] + (size_t)m * DM, c.in[8], WSP(bf16, WS_H) + (size_t)m * DM, c.lane);
        else if (m < MT) rms_row_to_bf16(c.in[1] + (size_t)(m - MP) * DM, c.in[8], WSP(bf16, WS_H) + (size_t)m * DM, c.lane);
        else rms_row_to_bf16(c.in[2] + (size_t)(m - MT) * DM, c.in[21], WSP(bf16, WS_HM) + (size_t)(m - MT) * DM, c.lane);
    }
    { const size_t n8 = (size_t)NB * NMEM * 512 / 8; const f32x4* src = (const f32x4*)c.in[3]; u32x4* dst = WSP(u32x4, WS_KBS);
      for (size_t i = (size_t)c.bid * 512 + c.tid; i < n8; i += (size_t)c.G * 512) { const f32x4 a = src[2 * i], b = src[2 * i + 1]; u32x4 o; o.x = pk2(a.x, a.y); o.y = pk2(a.z, a.w); o.z = pk2(b.x, b.y); o.w = pk2(b.z, b.w); dst[i] = o; } }
}

DI int swz128(int row, int chunk) { return row * 128 + ((chunk ^ ((row >> 1) & 7)) << 4); }
DI void gemm_kloop(Ctx& c, f32x16 (&acc)[2], const bf16* A, int lda, const bf16* Bt, int ldb, int K, int m0, int n0) {
    const int tid = c.tid, lane = c.lane, w = c.wave, wr = w >> 1, wc = w & 1, r = lane & 31, h = lane >> 5;
    const int srow = tid >> 2, scp = tid & 3;
    const bf16* ga = A + (size_t)(m0 + srow) * lda + scp * 16;
    const bf16* gb = Bt + (size_t)(n0 + srow) * ldb + scp * 16;
    const int wo0 = swz128(srow, 2 * scp), wo1 = swz128(srow, 2 * scp + 1);
    const int nk = K / 64;
    u32x4 ra0, ra1, rb0, rb1;
    ra0 = *(const u32x4*)(ga); ra1 = *(const u32x4*)(ga + 8); rb0 = *(const u32x4*)(gb); rb1 = *(const u32x4*)(gb + 8);
    __syncthreads();
    *(LAS u32x4*)(c.lds + wo0) = ra0; *(LAS u32x4*)(c.lds + wo1) = ra1; *(LAS u32x4*)(c.lds + 16384 + wo0) = rb0; *(LAS u32x4*)(c.lds + 16384 + wo1) = rb1;
    __syncthreads();
    for (int kt = 0; kt < nk; ++kt) {
        const int cur = (kt & 1) * 32768, nxt = 32768 - cur;
        if (kt + 1 < nk) { const bf16* pa = ga + (kt + 1) * 64; const bf16* pb = gb + (kt + 1) * 64;
            ra0 = *(const u32x4*)(pa); ra1 = *(const u32x4*)(pa + 8); rb0 = *(const u32x4*)(pb); rb1 = *(const u32x4*)(pb + 8); }
#pragma unroll
        for (int s = 0; s < 4; ++s) {
            const bf16x8 af = *(const LAS bf16x8*)(c.lds + cur + swz128(32 * wr + r, 2 * s + h));
#pragma unroll
            for (int j = 0; j < 2; ++j) {
                const bf16x8 bfr = *(const LAS bf16x8*)(c.lds + cur + 16384 + swz128(64 * wc + 32 * j + r, 2 * s + h));
                acc[j] = MFMA32(bfr, af, acc[j]);
            }
        }
        if (kt + 1 < nk) { *(LAS u32x4*)(c.lds + nxt + wo0) = ra0; *(LAS u32x4*)(c.lds + nxt + wo1) = ra1; *(LAS u32x4*)(c.lds + nxt + 16384 + wo0) = rb0; *(LAS u32x4*)(c.lds + nxt + 16384 + wo1) = rb1; }
        __syncthreads();
    }
}
template <class Epi> DI void gemm_epi(Ctx& c, const f32x16 (&acc)[2], int m0, int n0, const Epi& E) {
    const int lane = c.lane, w = c.wave, wr = w >> 1, wc = w & 1, r = lane & 31, h = lane >> 5;
    const int m = m0 + 32 * wr + r;
#pragma unroll
    for (int j = 0; j < 2; ++j)
#pragma unroll
        for (int g = 0; g < 4; ++g) { const int n = n0 + 64 * wc + 32 * j + 8 * g + 4 * h; E(m, n, (f32x4){acc[j][4 * g], acc[j][4 * g + 1], acc[j][4 * g + 2], acc[j][4 * g + 3]}); }
}
template <class Epi> DI void gemm_tile(Ctx& c, const bf16* A, int lda, const bf16* Bt, int ldb, int K, int m0, int n0, const Epi& E) {
    f32x16 acc[2];
#pragma unroll
    for (int j = 0; j < 2; ++j)
#pragma unroll
        for (int i = 0; i < 16; ++i) acc[j][i] = 0.f;
    gemm_kloop(c, acc, A, lda, Bt, ldb, K, m0, n0);
    gemm_epi(c, acc, m0, n0, E);
}

struct EpiZ {
    bf16* Z; float* out;
    DI void operator()(int m, int n, f32x4 v) const {
        if (n >= ZC_XB && n < ZC_GB) {
            int b, t3;
            if (m < MP) { b = m >> 11; t3 = (m & 2047) - 2045; } else { b = (m - MP) >> 5; t3 = ((m - MP) & 31) - 29; }
            if (t3 >= 0) { float* o = out + (m < MP ? O_CP : O_CS) + (size_t)(b * 3 + t3) * 1024 + (n - ZC_XB); *(f32x4*)o = v; }
        }
        const bool act = (n < ZC_FA) || (n >= ZC_GA && n < ZC_XB) || (n >= ZC_GB && n < ZC_QC) || (n >= ZC_GC);
        if (act) { v.x = silu(v.x); v.y = silu(v.y); v.z = silu(v.z); v.w = silu(v.w); }
        if (n >= ZC_QC && n < ZC_GC) { v = v * QSCALE; }
        u32x2 o; o.x = pk2(v.x, v.y); o.y = pk2(v.z, v.w);
        *(u32x2*)(Z + (size_t)m * ZP + n) = o;
    }
};
struct EpiMK {
    bf16* KB; float* out;
    DI void operator()(int m, int n, f32x4 v) const {
        *(f32x4*)(out + O_MK + (size_t)m * 512 + n) = v;
        u32x2 o; o.x = pk2(v.x, v.y); o.y = pk2(v.z, v.w); *(u32x2*)(KB + (size_t)m * 512 + n) = o;
    }
};
struct EpiMV {
    bf16* VT; float* out;
    DI void operator()(int nn, int m, f32x4 v) const {
        float* o = out + O_MV + (size_t)m * 512 + nn; o[0] = v.x; o[512] = v.y; o[1024] = v.z; o[1536] = v.w;
        const int b = m >> 8; u32x2 p; p.x = pk2(v.x, v.y); p.y = pk2(v.z, v.w);
        *(u32x2*)(VT + ((size_t)b * 512 + nn) * 256 + (m & 255)) = p;
    }
};
struct EpiMG { bf16* Z; DI void operator()(int m, int n, f32x4 v) const { u32x2 o; o.x = pk2(v.x, v.y); o.y = pk2(v.z, v.w); *(u32x2*)(Z + (size_t)m * ZP + ZC_MG + n) = o; } };
struct EpiY {
    const float* xp; const float* xs; float* out;
    DI void operator()(int m, int n, f32x4 v) const {
        const float* x = (m < MP) ? xp + (size_t)m * DM + n : xs + (size_t)(m - MP) * DM + n;
        const f32x4 xv = *(const f32x4*)x;
        *(f32x4*)(out + (size_t)m * DM + n) = xv + v;
    }
};


namespace pgx {
constexpr int BM = 256, BK = 64, HALF = 128, HTB = HALF * BK * 2, STAGE_BYTES = 8 * HTB, NXCD = 8, WGM = 8;
DI int lds_byte(int r, int c) { const int st = (r >> 4) * 2 + (c >> 5), rr = r & 15, cc = c & 31, ob = rr * 64 + cc * 2; return st * 1024 + (ob ^ (((ob >> 9) & 1) << 5)); }
DI void stage_rc(int b, int& R, int& C) { const int st = b / 1024, sb = b % 1024, swz = sb ^ (((sb >> 9) & 1) << 5); R = (st >> 1) * 16 + swz / 64; C = (st & 1) * 32 + (swz % 64) / 2; }
DI int perm32(int rho) { const int n = rho >> 4, i = rho & 15; return 8 * (i >> 2) + 4 * n + (i & 3); }
struct Unit { const char* A; const char* B; int nt, pm, pn, seg, za; };
DI bool static_tile(int i, int G, int c, int nM, int nN, int& pm, int& pn) {
    const int nwg = nM * nN; const long L = (long)i * G + c; if (L >= nwg) return false;
    int wgid = (int)L; { const int q = nwg / NXCD, r = nwg % NXCD, xcd = wgid % NXCD, off = wgid / NXCD; wgid = (xcd < r ? xcd * (q + 1) : r * (q + 1) + (xcd - r) * q) + off; }
    const int nig = WGM * nN, gid = wgid / nig, fm = gid * WGM, gsz = (nM - fm) < WGM ? (nM - fm) : WGM;
    pm = fm + ((wgid % nig) % gsz); pn = (wgid % nig) / gsz; return true;
}
template <class Epi, class Sched>
DI void gemm_phase(LAS unsigned char* lds, const int lda0, const int lda1, const int ldb, const Sched& S, Epi& E) {
    const int tid = threadIdx.x, wid = __builtin_amdgcn_readfirstlane(tid >> 6), lane = tid & 63, wr = wid >> 2, wc = wid & 3, fr = lane & 15, fq = lane >> 4;
    unsigned vA0[2], vA1[2], voffB[2];
#pragma unroll
    for (int i = 0; i < 2; ++i) { int R, C; stage_rc(tid * 16 + i * 8192, R, C); const int Rb = Epi::PERM ? ((R & ~31) + perm32(R & 31)) : R;
        vA0[i] = (unsigned)(R * lda0 + C) * 2u; vA1[i] = (unsigned)(R * lda1 + C) * 2u; voffB[i] = (unsigned)(Rb * ldb + C) * 2u; }
    const size_t kstep = (size_t)(BK * 2);
    const size_t hsA0 = (size_t)HALF * lda0 * 2, hsA1 = (size_t)HALF * lda1 * 2, hstepB = (size_t)HALF * ldb * 2;
    const unsigned ldsw = (unsigned)wid * 1024u;
    const int aoff = lds_byte(wr * 64 + fr, fq * 8), boff = lds_byte(wc * 32 + fr, fq * 8);
#define PG8_SA(b, h) (((b) * 2 + (h)) * HTB)
#define PG8_SB(b, h) ((4 + (b) * 2 + (h)) * HTB)
#define PG8_STAGE(bufoff, gbase, voff) do { _Pragma("unroll") for (int _i = 0; _i < 2; ++_i) \
        __builtin_amdgcn_global_load_lds((const unsigned*)((const char*)(gbase) + (voff)[_i]), (LAS unsigned*)(lds + (bufoff) + ldsw + _i * 8192), 16, 0, 0); } while (0)
#define PG8_LDA(dst, b, h) do { _Pragma("unroll") for (int m = 0; m < 4; ++m) _Pragma("unroll") for (int k = 0; k < 2; ++k) dst[m][k] = *(const LAS bf16x8*)(lds + PG8_SA(b, h) + aoff + m * 2048 + k * 1024); } while (0)
#define PG8_LDB(dst, b, h) do { _Pragma("unroll") for (int n = 0; n < 2; ++n) _Pragma("unroll") for (int k = 0; k < 2; ++k) dst[n][k] = *(const LAS bf16x8*)(lds + PG8_SB(b, h) + boff + n * 2048 + k * 1024); } while (0)
#define PG8_MMA(ai, bj, At, Bt) do { __builtin_amdgcn_s_setprio(1); _Pragma("unroll") for (int m = 0; m < 4; ++m) _Pragma("unroll") for (int n = 0; n < 2; ++n) _Pragma("unroll") for (int k = 0; k < 2; ++k) \
        acc[ai][bj][m][n] = __builtin_amdgcn_mfma_f32_16x16x32_bf16(Bt[n][k], At[m][k], acc[ai][bj][m][n], 0, 0, 0); __builtin_amdgcn_s_setprio(0); } while (0)
#define PG8_WAIT_V(n) asm volatile("s_waitcnt vmcnt(" #n ")" ::: "memory")
#define PG8_WAIT_L(n) asm volatile("s_waitcnt lgkmcnt(" #n ")" ::: "memory")
#define PG8_BAR __builtin_amdgcn_s_barrier()
#define PG8_SCHED __builtin_amdgcn_sched_barrier(0)
    Unit cur, nxt; int ui = 0;
    if (!S.next(0, cur)) return;
    f32x4 acc[2][2][4][2];
#pragma unroll
    for (int a = 0; a < 2; ++a)
#pragma unroll
        for (int b = 0; b < 2; ++b)
#pragma unroll
            for (int m = 0; m < 4; ++m)
#pragma unroll
                for (int n = 0; n < 2; ++n) acc[a][b][m][n] = (f32x4){0.f, 0.f, 0.f, 0.f};
    bf16x8 At[4][2], B0[2][2], B1[2][2];
    const char* cA = cur.A; const char* cB = cur.B;
    unsigned voffA[2]; voffA[0] = cur.za ? vA1[0] : vA0[0]; voffA[1] = cur.za ? vA1[1] : vA0[1];
    size_t hstepA = cur.za ? hsA1 : hsA0;
    PG8_STAGE(PG8_SB(0, 0), cB, voffB); PG8_STAGE(PG8_SB(0, 1), cB + hstepB, voffB); PG8_STAGE(PG8_SA(0, 0), cA, voffA); PG8_STAGE(PG8_SA(0, 1), cA + hstepA, voffA);
    if (wr == 1) PG8_BAR;
    PG8_WAIT_V(2); PG8_BAR;
    PG8_STAGE(PG8_SB(1, 0), cB + kstep, voffB); PG8_STAGE(PG8_SA(1, 0), cA + kstep, voffA); PG8_STAGE(PG8_SB(1, 1), cB + hstepB + kstep, voffB);
    PG8_WAIT_V(6); PG8_BAR;
    for (;;) {
        const bool has_next = S.next(ui + 1, nxt);
        const char* nA = has_next ? nxt.A : cA; const char* nB = has_next ? nxt.B : cB;
        const int nt = cur.nt;
        const bool nza = has_next ? (nxt.za != 0) : (cur.za != 0);
        for (int t = 0; t < nt; t += 2) {
            const bool last = (t == nt - 2);
            unsigned voffN[2]; voffN[0] = last ? (nza ? vA1[0] : vA0[0]) : voffA[0]; voffN[1] = last ? (nza ? vA1[1] : vA0[1]) : voffA[1];
            const size_t hstepN = last ? (nza ? hsA1 : hsA0) : hstepA;
            const char* a1 = cA + (size_t)(t + 1) * kstep;
            const char* a2 = last ? nA : cA + (size_t)(t + 2) * kstep; const char* b2 = last ? nB : cB + (size_t)(t + 2) * kstep;
            const char* a3 = a2 + kstep; const char* b3 = b2 + kstep;
            PG8_LDB(B0, 0, 0); PG8_LDB(B1, 0, 1); PG8_SCHED; PG8_LDA(At, 0, 0); PG8_STAGE(PG8_SA(1, 1), a1 + hstepA, voffA);
            PG8_WAIT_V(8); PG8_WAIT_L(0); PG8_BAR; PG8_MMA(0, 0, At, B0); PG8_MMA(0, 1, At, B1); PG8_BAR; PG8_SCHED;
            PG8_LDA(At, 0, 1); PG8_STAGE(PG8_SB(0, 0), b2, voffB); PG8_STAGE(PG8_SB(0, 1), b2 + hstepB, voffB); PG8_STAGE(PG8_SA(0, 0), a2, voffN);
            PG8_WAIT_V(8); PG8_WAIT_L(0); PG8_BAR; PG8_MMA(1, 0, At, B0); PG8_MMA(1, 1, At, B1); PG8_BAR; PG8_SCHED;
            PG8_LDB(B0, 1, 0); PG8_LDB(B1, 1, 1); PG8_SCHED; PG8_LDA(At, 1, 0); PG8_STAGE(PG8_SA(0, 1), a2 + hstepN, voffN);
            PG8_WAIT_V(8); PG8_WAIT_L(0); PG8_BAR; PG8_MMA(0, 0, At, B0); PG8_MMA(0, 1, At, B1); PG8_BAR; PG8_SCHED;
            PG8_LDA(At, 1, 1); PG8_STAGE(PG8_SB(1, 0), b3, voffB); PG8_STAGE(PG8_SB(1, 1), b3 + hstepB, voffB); PG8_STAGE(PG8_SA(1, 0), a3, voffN);
            PG8_WAIT_V(8); PG8_WAIT_L(0); PG8_BAR; PG8_MMA(1, 0, At, B0); PG8_MMA(1, 1, At, B1); PG8_BAR; PG8_SCHED;
        }
        if (wr == 0) PG8_BAR;
        E(acc, cur, wr, wc, fr, fq);
        if (!has_next) break;
#pragma unroll
        for (int a = 0; a < 2; ++a)
#pragma unroll
            for (int b = 0; b < 2; ++b)
#pragma unroll
                for (int m = 0; m < 4; ++m)
#pragma unroll
                    for (int n = 0; n < 2; ++n) acc[a][b][m][n] = (f32x4){0.f, 0.f, 0.f, 0.f};
        cur = nxt; cA = nA; cB = nB; ++ui;
        voffA[0] = cur.za ? vA1[0] : vA0[0]; voffA[1] = cur.za ? vA1[1] : vA0[1]; hstepA = cur.za ? hsA1 : hsA0;
        if (wr == 1) PG8_BAR;
    }
    PG8_WAIT_V(0);
    PG8_BAR;
#undef PG8_SA
#undef PG8_SB
#undef PG8_STAGE
#undef PG8_LDA
#undef PG8_LDB
#undef PG8_MMA
#undef PG8_WAIT_V
#undef PG8_WAIT_L
#undef PG8_BAR
#undef PG8_SCHED
}
}

struct SchedG1 {
    const char* A; const char* B; int G, c;
    DI bool next(int i, pgx::Unit& u) const {
        int pm, pn; if (!pgx::static_tile((PROBE_REP == 11) ? (i >> 1) : i, G, c, MP / 256, ZP / 256, pm, pn)) return false;
        u.pm = pm; u.pn = pn; u.seg = 0; u.za = 0; u.nt = DM / 64; u.A = A + (size_t)pm * 256 * DM * 2; u.B = B + (size_t)pn * 256 * DM * 2; return true;
    }
};
struct EpiG1 {
    static constexpr bool PERM = true;
    bf16* Z; float* out;
    DI void operator()(const f32x4 (&acc)[2][2][4][2], const pgx::Unit& u, int wr, int wc, int fr, int fq) const {
        const int colt = u.pn * 256;
        const bool act = (colt < ZC_FA) || (colt >= ZC_GA && colt < ZC_XB) || (colt >= ZC_GB && colt < ZC_QC) || (colt >= ZC_GC);
        const float sc = (colt >= ZC_QC && colt < ZC_GC) ? QSCALE : 1.0f;
        const bool convt = (colt >= ZC_XB && colt < ZC_GB) && ((u.pm & 7) == 7);
        const int row0 = u.pm * 256 + wr * 64 + fr, col0 = colt + wc * 32 + 8 * fq;
#pragma unroll
        for (int ai = 0; ai < 2; ++ai)
#pragma unroll
            for (int m = 0; m < 4; ++m) { const int row = row0 + ai * 128 + m * 16; bf16* rowp = Z + (size_t)row * ZP + col0;
#pragma unroll
                for (int bj = 0; bj < 2; ++bj) { f32x4 v0 = acc[ai][bj][m][0], v1 = acc[ai][bj][m][1];
                    if (convt) { const int t3 = (row & 2047) - 2045; if (t3 >= 0) { float* o = out + O_CP + (size_t)((row >> 11) * 3 + t3) * 1024 + (col0 + bj * 128 - ZC_XB); *(f32x4*)o = v0; *(f32x4*)(o + 4) = v1; } }
                    if (act) { v0.x = silu(v0.x); v0.y = silu(v0.y); v0.z = silu(v0.z); v0.w = silu(v0.w); v1.x = silu(v1.x); v1.y = silu(v1.y); v1.z = silu(v1.z); v1.w = silu(v1.w); }
                    v0 = v0 * sc; v1 = v1 * sc;
                    u32x4 w; w.x = pk2(v0.x, v0.y); w.y = pk2(v0.z, v0.w); w.z = pk2(v1.x, v1.y); w.w = pk2(v1.z, v1.w);
                    *(u32x4*)(rowp + bj * 128) = w; } }
    }
};

DI void phase_g1(Ctx& c) {
    { SchedG1 S{(const char*)WSP(bf16, WS_H), (const char*)WSP(bf16, WS_WIN), c.G, c.bid}; EpiG1 E{WSP(bf16, WS_Z), c.out};
      pgx::gemm_phase(c.lds, DM, DM, DM, S, E); }
    constexpr int T_Z = (MS / 128) * (ZP / 128), T_K = 16 * 4, T_V = 4 * 16;
    for (int it = c.bid; it < T_Z + T_K + T_V; it += c.G) {
        if (it < T_Z) { const int tm = it / (ZP / 128), tn = it % (ZP / 128);
            gemm_tile(c, WSP(bf16, WS_H), DM, WSP(bf16, WS_WIN), DM, DM, MP + tm * 128, tn * 128, EpiZ{WSP(bf16, WS_Z), c.out}); }
        else if (it < T_Z + T_K) { const int i = it - T_Z, tm = i >> 2, tn = i & 3;
            gemm_tile(c, WSP(bf16, WS_HM), DM, WSP(bf16, WS_WMEM), DM, DM, tm * 128, tn * 128, EpiMK{WSP(bf16, WS_KBP), c.out}); }
        else { const int i = it - T_Z - T_K, tm = i >> 4, tn = i & 15;
            gemm_tile(c, WSP(bf16, WS_WMEM) + (size_t)512 * DM, DM, WSP(bf16, WS_HM), DM, DM, tm * 128, tn * 128, EpiMV{WSP(bf16, WS_VTP), c.out}); }
    }
}

struct SchedG3 {
    const char* ws; int G, c;
    DI bool next(int i, pgx::Unit& u) const {
        const int r = i / 6, sg = i - 6 * r; int pm, pn; if (!pgx::static_tile((PROBE_REP == 15) ? (r >> 1) : r, G, c, MP / 256, 4, pm, pn)) return false;
        const int br = sg >> 1; u.pm = pm; u.pn = pn; u.seg = sg;
        static_assert(WS_WB == WS_WA + 2 * MiB && WS_WC == WS_WA + 4 * MiB && ZC_GB == 2 * ZC_GA && ZC_GC == 3 * ZC_GA, "branch strides");
        if ((sg & 1) == 0) { u.za = 0; u.nt = 16; u.A = ws + WS_H + (size_t)pm * 256 * DM * 2; u.B = ws + WS_WIN + (size_t)(5120 + 1024 * br + 256 * pn) * DM * 2; }
        else { u.za = 1; u.nt = (br == 1) ? 16 : 8;
            u.A = ws + WS_Z + ((size_t)pm * 256 * ZP + (size_t)ZC_GA * (br + 1)) * 2; u.B = ws + WS_WA + (size_t)br * 2 * MiB + (size_t)(256 * pn) * DM * 2; }
        return true;
    }
};
struct EpiG3 {
    static constexpr bool PERM = true;
    bf16* Z;
    DI void operator()(const f32x4 (&acc)[2][2][4][2], const pgx::Unit& u, int wr, int wc, int fr, int fq) const {
        const int row0 = u.pm * 256 + wr * 64 + fr, col0 = u.pn * 256 + wc * 32 + 8 * fq, sg = u.seg;
#pragma unroll
        for (int ai = 0; ai < 2; ++ai)
#pragma unroll
            for (int m = 0; m < 4; ++m) { bf16* rowp = Z + (size_t)(row0 + ai * 128 + m * 16) * ZP;
#pragma unroll
                for (int bj = 0; bj < 2; ++bj) { const int col = col0 + bj * 128; const int mcol = (col < 512) ? 1024 + col : 1536 + col;
                    const f32x4 v0 = acc[ai][bj][m][0], v1 = acc[ai][bj][m][1];
                    u32x4 w;
                    if ((sg & 1) == 0) { w.x = pk2(sigm(v0.x), sigm(v0.y)); w.y = pk2(sigm(v0.z), sigm(v0.w)); w.z = pk2(sigm(v1.x), sigm(v1.y)); w.w = pk2(sigm(v1.z), sigm(v1.w)); *(u32x4*)(rowp + col) = w; }
                    else {
                        float g[8], mo[8]; unpack8(*(const u32x4*)(rowp + col), g);
                        { u32x4 mw = *(const u32x4*)(rowp + mcol); if (sg == 1) mw = (u32x4){0u, 0u, 0u, 0u}; unpack8(mw, mo); }
                        w.x = pk2(mo[0] + g[0] * v0.x, mo[1] + g[1] * v0.y); w.y = pk2(mo[2] + g[2] * v0.z, mo[3] + g[3] * v0.w);
                        w.z = pk2(mo[4] + g[4] * v1.x, mo[5] + g[5] * v1.y); w.w = pk2(mo[6] + g[6] * v1.z, mo[7] + g[7] * v1.w);
                        *(u32x4*)(rowp + (sg == 5 ? col : mcol)) = w;
                    } }
                asm volatile("" ::: "memory"); }
    }
};
struct SchedG4 {
    const char* Zb; const char* WO; int G, c;
    DI bool next(int i, pgx::Unit& u) const {
        int pm, pn; if (!pgx::static_tile((PROBE_REP == 16) ? (i >> 1) : i, G, c, MP / 256, 4, pm, pn)) return false;
        u.pm = pm; u.pn = pn; u.seg = 0; u.za = 1; u.nt = 16; u.A = Zb + ((size_t)pm * 256 * ZP + ZC_MG) * 2; u.B = WO + (size_t)(256 * pn) * DM * 2; return true;
    }
};
struct EpiG4 {
    static constexpr bool PERM = false;
    const float* x; float* out;
    DI void operator()(const f32x4 (&acc)[2][2][4][2], const pgx::Unit& u, int wr, int wc, int fr, int fq) const {
        const int row0 = u.pm * 256 + wr * 64 + fr, col0 = u.pn * 256 + wc * 32 + 4 * fq;
#pragma unroll
        for (int ai = 0; ai < 2; ++ai)
#pragma unroll
            for (int m = 0; m < 4; ++m) { const size_t off = (size_t)(row0 + ai * 128 + m * 16) * DM + col0;
#pragma unroll
                for (int bj = 0; bj < 2; ++bj)
#pragma unroll
                    for (int n = 0; n < 2; ++n) { const f32x4 xv = *(const f32x4*)(x + off + bj * 128 + n * 16); *(f32x4*)(out + off + bj * 128 + n * 16) = xv + acc[ai][bj][m][n]; } }
    }
};

DI void phase_g3(Ctx& c) {
    { SchedG3 S{(const char*)c.ws, c.G, c.bid};
      EpiG3 E{WSP(bf16, WS_Z)}; pgx::gemm_phase(c.lds, DM, ZP, DM, S, E); }
    constexpr int NT = (MS / 128) * 8;
    const bf16* Z = WSP(bf16, WS_Z);
    for (int it = c.bid; it < NT; it += c.G) {
        const int m0 = MP + (it >> 3) * 128, n0 = (it & 7) * 128;
        f32x16 M[2], P[2], Gt[2];
#pragma unroll
        for (int j = 0; j < 2; ++j)
#pragma unroll
            for (int i = 0; i < 16; ++i) M[j][i] = 0.f;
#pragma unroll 1
        for (int br = 0; br < 3; ++br) {
#pragma unroll
            for (int j = 0; j < 2; ++j)
#pragma unroll
                for (int i = 0; i < 16; ++i) P[j][i] = 0.f;
            gemm_kloop(c, P, WSP(bf16, WS_H), DM, WSP(bf16, WS_WIN) + (size_t)(5120 + 1024 * br) * DM, DM, DM, m0, n0);
#pragma unroll
            for (int j = 0; j < 2; ++j)
#pragma unroll
                for (int i = 0; i < 16; ++i) { Gt[j][i] = sigm(P[j][i]); P[j][i] = 0.f; }
            const bf16* Y = Z + (br == 0 ? ZC_GA : br == 1 ? ZC_GB : ZC_GC);
            const bf16* W = br == 0 ? WSP(bf16, WS_WA) : br == 1 ? WSP(bf16, WS_WB) : WSP(bf16, WS_WC);
            const int Kb = br == 1 ? 1024 : 512;
            gemm_kloop(c, P, Y, ZP, W, DM, Kb, m0, n0);
#pragma unroll
            for (int j = 0; j < 2; ++j)
#pragma unroll
                for (int i = 0; i < 16; ++i) M[j][i] += Gt[j][i] * P[j][i];
        }
        gemm_epi(c, M, m0, n0, EpiMG{WSP(bf16, WS_Z)});
    }
}
DI void phase_g4(Ctx& c) {
    { SchedG4 S{(const char*)WSP(bf16, WS_Z), (const char*)WSP(bf16, WS_WOUT), c.G, c.bid}; EpiG4 E{c.in[0], c.out}; pgx::gemm_phase(c.lds, DM, ZP, DM, S, E); }
    constexpr int NT = (MS / 128) * 8;
    for (int it = c.bid; it < NT; it += c.G) {
        const int m0 = MP + (it >> 3) * 128, n0 = (it & 7) * 128;
        gemm_tile(c, WSP(bf16, WS_Z) + ZC_MG, ZP, WSP(bf16, WS_WOUT), DM, DM, m0, n0, EpiY{c.in[0], c.in[1], c.out});
    }
}
template <bool DUMMY> DI void phase_final(Ctx& c) {
    const int gw = c.bid * 8 + c.wave, NGW = c.G * 8;
    for (int m = gw; m < MT; m += NGW) {
        f32x4* xr = (f32x4*)(c.out + (size_t)m * DM) + c.lane; const f32x4* gr = (const f32x4*)c.in[26] + c.lane;
        f32x4 v[4]; float s = 0.f;
#pragma unroll
        for (int j = 0; j < 4; ++j) { v[j] = xr[64 * j]; s += (v[j].x * v[j].x + v[j].y * v[j].y) + (v[j].z * v[j].z + v[j].w * v[j].w); }
        const float rs = __builtin_amdgcn_rsqf(wave_sum(s) * (1.f / DM) + EPS);
        f32x4* orow = DUMMY ? (f32x4*)(c.ws + WS_Z + (size_t)m * DM * 4) + c.lane : xr;
#pragma unroll
        for (int j = 0; j < 4; ++j) { const f32x4 gg = gr[64 * j]; orow[64 * j] = v[j] * rs * gg; }
    }
}

constexpr int A_BL = 0, A_SEG = 32768, A_BLAST = 34816, A_SS = 35328, A_QG = 36864, A_KG = 53248, A_ATT = 69632, A_VT = 77824, A_KPT = 94208;
DI int swz256(int row, int chunk) { return row * 256 + ((chunk ^ (row & 15)) << 4); }
template <int MODE>
DI void hgrn_item(Ctx& c, int mrow0, int valid, int h, const bf16* STin, bf16* STout, float* DCout, const float* s0, float* snew, int ocol = ZC_GA) {
    const int tid = c.tid, lane = c.lane, w = c.wave, r = lane & 31, hh = lane >> 5;
    bf16* Z = WSP(bf16, WS_Z);
    LAS unsigned char* L = c.lds;
    LAS float* BL = (LAS float*)(L + A_BL); LAS float* SEG = (LAS float*)(L + A_SEG); LAS float* BLAST = (LAS float*)(L + A_BLAST); LAS float* SS = (LAS float*)(L + A_SS);
    const float* lbl = c.in[10];
    const int t = tid >> 3, k16 = (tid & 7) * 16;
    const bool tv = t < valid;
#pragma unroll 1
    for (int half = 0; half < 2; ++half) {
        const int k8 = k16 + 8 * half;
        float fa[8], vv[8];
        if (tv) { const bf16* zr = Z + (size_t)(mrow0 + t) * ZP + h * 128 + k8;
            unpack8(*(const u32x4*)(zr + ZC_FA), fa); unpack8(*(const u32x4*)(zr + ZC_VA), vv);
        } else {
#pragma unroll
            for (int i = 0; i < 8; ++i) { fa[i] = 0.f; vv[i] = 0.f; }
        }
#pragma unroll
        for (int i = 0; i < 8; ++i) {
            const int k = h * 128 + k8 + i;
            const float lb = frcp(1.0f + __expf(lbl[512 + k] - lbl[k]));
            const float f = lb + (1.0f - lb) * sigm(fa[i]);
            BL[t * 128 + k8 + i] = tv ? __logf(f) : 0.f;
            const int v = k8 + i;
            *(LAS unsigned short*)(L + A_VT + swz128(v, t >> 3) + (t & 7) * 2) = (unsigned short)(pk2(vv[i], 0.f) & 0xffffu);
        }
    }
    __syncthreads();
    {
        const int k = tid & 127, seg = tid >> 7; float run = 0.f;
#pragma unroll
        for (int i = 0; i < 16; ++i) { run += BL[(16 * seg + i) * 128 + k]; BL[(16 * seg + i) * 128 + k] = run; }
        SEG[seg * 128 + k] = run;
        __syncthreads();
        float off = 0.f;
#pragma unroll
        for (int s = 0; s < 3; ++s) if (s < seg) off += SEG[s * 128 + k];
        if (seg > 0) {
#pragma unroll
            for (int i = 0; i < 16; ++i) BL[(16 * seg + i) * 128 + k] += off;
        }
        if (seg == 3) BLAST[k] = off + run;
        __syncthreads();
    }
#pragma unroll 1
    for (int half = 0; half < 2; ++half) {
        const int k8 = k16 + 8 * half;
        float bb[8], omf[8];
#pragma unroll
        for (int i = 0; i < 8; ++i) bb[i] = BL[t * 128 + k8 + i];
        {
            float fa[8];
            if (tv) unpack8(*(const u32x4*)(Z + (size_t)(mrow0 + t) * ZP + ZC_FA + h * 128 + k8), fa);
            else {
#pragma unroll
                for (int i = 0; i < 8; ++i) fa[i] = 0.f;
            }
#pragma unroll
            for (int i = 0; i < 8; ++i) { const int k = h * 128 + k8 + i; const float lb = frcp(1.0f + __expf(lbl[512 + k] - lbl[k])); omf[i] = tv ? (1.0f - lb) * (1.0f - sigm(fa[i])) : 0.f; }
        }
        if (MODE & 2) {
            float q[8];
            if (tv) unpack8(*(const u32x4*)(Z + (size_t)(mrow0 + t) * ZP + ZC_QA + h * 128 + k8), q);
            else {
#pragma unroll
                for (int i = 0; i < 8; ++i) q[i] = 0.f;
            }
            float qg[8], kg[8];
#pragma unroll
            for (int i = 0; i < 8; ++i) { qg[i] = q[i] * __expf(bb[i]); kg[i] = omf[i] * __expf(-bb[i]); }
            u32x4 oq, ok;
            oq.x = pk2(qg[0], qg[1]); oq.y = pk2(qg[2], qg[3]); oq.z = pk2(qg[4], qg[5]); oq.w = pk2(qg[6], qg[7]);
            ok.x = pk2(kg[0], kg[1]); ok.y = pk2(kg[2], kg[3]); ok.z = pk2(kg[4], kg[5]); ok.w = pk2(kg[6], kg[7]);
            *(LAS u32x4*)(L + A_QG + swz256(t, k8 >> 3)) = oq;
            *(LAS u32x4*)(L + A_KG + swz256(t, k8 >> 3)) = ok;
        }
        if (MODE & 1) {
#pragma unroll
            for (int i = 0; i < 8; ++i) { const int k = k8 + i; const float kp = omf[i] * __expf(BLAST[k] - bb[i]);
                *(LAS unsigned short*)(L + A_KPT + swz128(k, t >> 3) + (t & 7) * 2) = (unsigned short)(pk2(kp, 0.f) & 0xffffu); }
        }
    }
    __syncthreads();
    if (MODE & 1) {
        const int kt = w & 3, vp = w >> 2;
        f32x16 acc[2];
#pragma unroll
        for (int j = 0; j < 2; ++j)
#pragma unroll
            for (int i = 0; i < 16; ++i) acc[j][i] = 0.f;
#pragma unroll
        for (int s = 0; s < 4; ++s) {
            const bf16x8 a = *(const LAS bf16x8*)(L + A_KPT + swz128(32 * kt + r, 2 * s + hh));
#pragma unroll
            for (int j = 0; j < 2; ++j) { const bf16x8 b = *(const LAS bf16x8*)(L + A_VT + swz128(32 * (2 * vp + j) + r, 2 * s + hh)); acc[j] = MFMA32(a, b, acc[j]); }
        }
        if (MODE == 1) {
#pragma unroll
            for (int j = 0; j < 2; ++j) { const int v = 32 * (2 * vp + j) + r;
#pragma unroll
                for (int g = 0; g < 4; ++g) { const int k = 32 * kt + 8 * g + 4 * hh; u32x2 o; o.x = pk2(acc[j][4 * g], acc[j][4 * g + 1]); o.y = pk2(acc[j][4 * g + 2], acc[j][4 * g + 3]);
                    *(u32x2*)(STout + v * 128 + k) = o; } }
            if (tid < 128) DCout[tid] = __expf(BLAST[tid]);
        } else {
#pragma unroll
            for (int j = 0; j < 2; ++j) { const int v = 32 * (2 * vp + j) + r;
#pragma unroll
                for (int g = 0; g < 4; ++g) {
#pragma unroll
                    for (int i = 4 * g; i < 4 * g + 4; ++i) { const int k = 32 * kt + crow(i, hh); snew[k * 128 + v] = __expf(BLAST[k]) * s0[k * 128 + v] + acc[j][i]; }
                    asm volatile("" ::: "memory"); } }
        }
    }
    if (MODE & 2) {
        if (w < 4) {
            const int si = w >> 1, tj = w & 1;
            f32x16 acc;
#pragma unroll
            for (int i = 0; i < 16; ++i) acc[i] = 0.f;
            if (si <= tj) {
#pragma unroll
                for (int s = 0; s < 8; ++s) { const bf16x8 a = *(const LAS bf16x8*)(L + A_KG + swz256(32 * si + r, 2 * s + hh)); const bf16x8 b = *(const LAS bf16x8*)(L + A_QG + swz256(32 * tj + r, 2 * s + hh)); acc = MFMA32(a, b, acc); }
            }
            const int tt = 32 * tj + r;
#pragma unroll
            for (int g = 0; g < 4; ++g) { const int s0_ = 32 * si + 8 * g + 4 * hh; float v[4];
#pragma unroll
                for (int i = 0; i < 4; ++i) v[i] = (s0_ + i <= tt) ? acc[4 * g + i] : 0.f;
                u32x2 o; o.x = pk2(v[0], v[1]); o.y = pk2(v[2], v[3]);
                *(LAS u32x2*)(L + A_ATT + swz128(tt, s0_ >> 3) + (s0_ & 7) * 2) = o; }
        }
        __syncthreads();
        const int vt = w & 3, tj = w >> 2;
        f32x16 acc;
#pragma unroll
        for (int i = 0; i < 16; ++i) acc[i] = 0.f;
#pragma unroll
        for (int s = 0; s < 4; ++s) { const bf16x8 a = *(const LAS bf16x8*)(L + A_VT + swz128(32 * vt + r, 2 * s + hh)); const bf16x8 b = *(const LAS bf16x8*)(L + A_ATT + swz128(32 * tj + r, 2 * s + hh)); acc = MFMA32(a, b, acc); }
        { const bf16* sp = STin + (32 * vt + r) * 128 + 8 * hh;
#pragma unroll
          for (int s = 0; s < 8; ++s) { const bf16x8 a = *(const bf16x8*)(sp + 16 * s); const bf16x8 b = *(const LAS bf16x8*)(L + A_QG + swz256(32 * tj + r, 2 * s + hh)); acc = MFMA32(a, b, acc); } }
        float ssq = 0.f;
#pragma unroll
        for (int i = 0; i < 16; ++i) ssq += acc[i] * acc[i];
        ssq += __shfl_xor(ssq, 32);
        const int tt = 32 * tj + r;
        if (hh == 0) SS[vt * 64 + tt] = ssq;
        __syncthreads();
        const float tot = (SS[tt] + SS[64 + tt]) + (SS[128 + tt] + SS[192 + tt]);
        const float rs = __builtin_amdgcn_rsqf(tot * (1.0f / 128.0f) + EPS);
        if (tt < valid) {
            const float* ga = c.in[11] + h * 128;
#pragma unroll
            for (int g = 0; g < 4; ++g) { const int v0 = 32 * vt + 8 * g + 4 * hh; bf16* zp = Z + (size_t)(mrow0 + tt) * ZP + ZC_GA + h * 128 + v0;
                float gg[4]; unpack4(*(const u32x2*)zp, gg); const f32x4 gw = *(const f32x4*)(ga + v0);
                u32x2 o; o.x = pk2(acc[4 * g] * rs * gw.x * gg[0], acc[4 * g + 1] * rs * gw.y * gg[1]); o.y = pk2(acc[4 * g + 2] * rs * gw.z * gg[2], acc[4 * g + 3] * rs * gw.w * gg[3]);
                *(u32x2*)(zp + (ocol - ZC_GA)) = o; }
        }
    }
    __syncthreads();
}

constexpr int NTT = SEQ / 32;
template <int MODE, bool DUMMY = false>
DI void lru_wave_item(Ctx& c, int b, int tt, int n) {
    const int lane = c.lane, w = c.wave, r = lane & 31, hh = lane >> 5;
    bf16* Z = WSP(bf16, WS_Z);
    LAS unsigned char* L = c.lds + w * 12288;
    LAS float* XCF = (LAS float*)(L + 4096);
    const int rowbase = (MODE == 2) ? MP + b * DSEQ : b * SEQ + 32 * tt;
    {
        const int t0 = 4 * (lane >> 3), g8 = lane & 7, ch = n * 64 + 8 * g8;
        float x[7][8];
#pragma unroll
        for (int i = 0; i < 7; ++i) {
            const int pos = ((MODE == 2) ? 0 : 32 * tt) + t0 + i - 3;
            if (pos >= 0) unpack8(*(const u32x4*)(Z + (size_t)(rowbase + t0 + i - 3) * ZP + ZC_XB + ch), x[i]);
            else if (MODE == 2) { const float* sc = c.in[6] + (size_t)(b * 3 + (pos + 3)) * 1024 + ch; const f32x4 a0 = *(const f32x4*)sc, a1 = *(const f32x4*)(sc + 4);
                x[i][0] = a0.x; x[i][1] = a0.y; x[i][2] = a0.z; x[i][3] = a0.w; x[i][4] = a1.x; x[i][5] = a1.y; x[i][6] = a1.z; x[i][7] = a1.w; }
            else {
#pragma unroll
                for (int q = 0; q < 8; ++q) x[i][q] = 0.f;
            }
        }
        float wv[4][8], bc[8];
        { const f32x4 b0 = *(const f32x4*)(c.in[14] + ch), b1 = *(const f32x4*)(c.in[14] + ch + 4); bc[0] = b0.x; bc[1] = b0.y; bc[2] = b0.z; bc[3] = b0.w; bc[4] = b1.x; bc[5] = b1.y; bc[6] = b1.z; bc[7] = b1.w; }
#pragma unroll
        for (int jj = 0; jj < 4; ++jj) { const f32x4 w0 = *(const f32x4*)(c.in[13] + jj * 1024 + ch), w1 = *(const f32x4*)(c.in[13] + jj * 1024 + ch + 4);
            wv[jj][0] = w0.x; wv[jj][1] = w0.y; wv[jj][2] = w0.z; wv[jj][3] = w0.w; wv[jj][4] = w1.x; wv[jj][5] = w1.y; wv[jj][6] = w1.z; wv[jj][7] = w1.w; }
#pragma unroll
        for (int tk = 0; tk < 4; ++tk) {
            float xc[8];
#pragma unroll
            for (int q = 0; q < 8; ++q) xc[q] = bc[q] + wv[0][q] * x[tk][q] + wv[1][q] * x[tk + 1][q] + wv[2][q] * x[tk + 2][q] + wv[3][q] * x[tk + 3][q];
            const int t = t0 + tk;
            *(LAS f32x4*)(XCF + t * 64 + 8 * g8) = (f32x4){xc[0], xc[1], xc[2], xc[3]}; *(LAS f32x4*)(XCF + t * 64 + 8 * g8 + 4) = (f32x4){xc[4], xc[5], xc[6], xc[7]};
            u32x4 o; o.x = pk2(xc[0], xc[1]); o.y = pk2(xc[2], xc[3]); o.z = pk2(xc[4], xc[5]); o.w = pk2(xc[6], xc[7]);
            *(LAS u32x4*)(L + swz128(t, g8)) = o;
        }
    }
#pragma unroll
    for (int ee = 0; ee < 2; ++ee) {
        const int e = 32 * ee + r, ch = n * 64 + e;
        f32x16 ar, ai;
#pragma unroll
        for (int i = 0; i < 16; ++i) { ar[i] = 0.f; ai[i] = 0.f; }
        { const bf16* Wr = WSP(bf16, WS_WLRU) + (size_t)n * 4096 + e * 64 + 8 * hh; const bf16* Wi = Wr + 65536;
#pragma unroll
          for (int s = 0; s < 4; ++s) { const bf16x8 a = *(const LAS bf16x8*)(L + swz128(r, 2 * s + hh)); ar = MFMA32(a, *(const bf16x8*)(Wr + 16 * s), ar); ai = MFMA32(a, *(const bf16x8*)(Wi + 16 * s), ai); } }
        const float sp = log1pf(__expf(-c.in[19][ch])), br_ = c.in[16][ch], bi_ = c.in[18][ch];
        float pc[16], hl[16];
#pragma unroll
        for (int g = 0; g < 4; ++g) { float pr = 1.f, hloc = 0.f;
#pragma unroll
            for (int q = 0; q < 4; ++q) { const int i = 4 * g + q, t = crow(i, hh);
                const float rg = sigm(ar[i] + br_), ig = sigm(ai[i] + bi_), xc = XCF[t * 64 + e];
                const float la = -8.0f * rg * sp, a = __expf(la);
                const float x2 = 2.0f * la;
                const float ser = -x2 * (1.0f + x2 * (0.5f + x2 * (0.16666667f + x2 * (0.041666668f + x2 * (0.0083333338f + x2 * 0.0013888889f)))));
                float mult = __builtin_amdgcn_sqrtf((x2 > -0.25f) ? ser : (1.0f - a * a));
                if (MODE != 2 && tt == 0 && t == 0) mult = 1.0f;
                hloc = a * hloc + mult * ig * xc; pr *= a; pc[i] = pr; hl[i] = hloc; } }
        float cg[4];
        float carry = (MODE == 0) ? 0.f : (MODE == 1) ? WSP(float, WS_CIN)[(size_t)(b * NTT + tt) * 1024 + ch] : c.in[7][b * 1024 + ch];
        float ptot = 1.f;
#pragma unroll
        for (int g = 0; g < 4; ++g) { const float pm = pc[4 * g + 3], hm = hl[4 * g + 3], po = __shfl_xor(pm, 32), ho = __shfl_xor(hm, 32);
            if (hh == 0) { cg[g] = carry; carry = pm * carry + hm; carry = po * carry + ho; }
            else { carry = po * carry + ho; cg[g] = carry; carry = pm * carry + hm; }
            ptot *= pm * po; }
        if (MODE == 0) { if (hh == 0) { float* ta = WSP(float, WS_TAGG) + ((size_t)(b * NTT + tt) * 1024 + ch) * 2; ta[0] = ptot; ta[1] = carry; } }
        else {
#pragma unroll
            for (int i = 0; i < 16; ++i) { const int t = crow(i, hh); const float hv = hl[i] + pc[i] * cg[i >> 2];
                bf16* zp = Z + (size_t)(rowbase + t) * ZP + ZC_GB + ch; bf16* op = DUMMY ? (bf16*)c.out + 16 * 1024 * 1024 + (size_t)(rowbase + t) * 1024 + ch : zp;
                *op = (unsigned short)(pk2(hv * bf2f(*zp), 0.f) & 0xffffu); }
            if (MODE == 2 && hh == 0) c.out[O_LS + b * 1024 + ch] = carry;
        }
    }
}

constexpr int C_K = 0, C_V = 65536;
DI int swzV(int row, int gi) { return row * 512 + (((gi >> 1) ^ (row & 15)) << 4) + (((gi & 1) ^ ((row >> 4) & 1)) << 3); }
DI void attn_item(Ctx& c, int item, bool dummy = false) {
    const int tid = c.tid, lane = c.lane, w = c.wave, r = lane & 31, hh = lane >> 5;
    LAS unsigned char* L = c.lds;
    bf16* Z = WSP(bf16, WS_Z);
    const bf16* KB; const bf16* VT; int m0, h, nw;
    if (item < 256) { const int b = item >> 5; h = (item >> 3) & 3; const int qg = item & 7; KB = WSP(bf16, WS_KBP) + (size_t)b * 256 * 512; VT = WSP(bf16, WS_VTP) + (size_t)b * 512 * 256; m0 = b * SEQ + 256 * qg + 32 * w; nw = 8; }
    else { const int i = item - 256, b = i >> 2; h = i & 3; KB = WSP(bf16, WS_KBS) + (size_t)b * 256 * 512; VT = WSP(bf16, WS_VTS) + (size_t)b * 512 * 256; m0 = MP + b * DSEQ; nw = 1; }
#pragma unroll
    for (int p = 0; p < 8; ++p) { const int e = p * 512 + tid, row = e >> 4, ch = e & 15;
        *(LAS u32x4*)(L + C_K + swz256(row, ch)) = *(const u32x4*)(KB + (size_t)row * 512 + h * 128 + ch * 8); }
    asm volatile("" ::: "memory");
#pragma unroll
    for (int p = 0; p < 8; ++p) { const int e = p * 512 + tid, row = e >> 5, ch = e & 31;
        u32x4 v = *(const u32x4*)(VT + (size_t)(h * 128 + row) * 256 + ch * 8);
        if (row & 16) v = (u32x4){v.z, v.w, v.x, v.y};
        *(LAS u32x4*)(L + C_V + row * 512 + ((ch ^ (row & 15)) << 4)) = v; }
    __syncthreads();
    if (w < nw) {
        const bf16* qp = Z + (size_t)(m0 + r) * ZP + ZC_QC + h * 128 + 8 * hh;
        f32x16 O[4];
#pragma unroll
        for (int d = 0; d < 4; ++d)
#pragma unroll
            for (int i = 0; i < 16; ++i) O[d][i] = 0.f;
        float mrun = -INFINITY, l = 0.f;
#pragma unroll 1
        for (int kc = 0; kc < 8; ++kc) {
            f32x16 S;
#pragma unroll
            for (int i = 0; i < 16; ++i) S[i] = 0.f;
            const int krow = 32 * kc + r;
#pragma unroll
            for (int s = 0; s < 8; ++s) { const bf16x8 a = *(const LAS bf16x8*)(L + C_K + swz256(krow, 2 * s + hh)); const bf16x8 qf = *(const bf16x8*)(qp + 16 * s); S = MFMA32(a, qf, S);
                if (s == 3) asm volatile("" ::: "memory"); }
            asm volatile("" ::: "memory");
            float mx = S[0];
#pragma unroll
            for (int i = 1; i < 16; ++i) mx = fmaxf(mx, S[i]);
            mx = fmaxf(mx, __shfl_xor(mx, 32));
            const float mnew = fmaxf(mrun, mx);
            const float alpha = exp2f(mrun - mnew);
            mrun = mnew; l *= alpha;
#pragma unroll
            for (int d = 0; d < 4; ++d)
#pragma unroll
                for (int i = 0; i < 16; ++i) O[d][i] *= alpha;
#pragma unroll
            for (int i = 0; i < 16; ++i) { const float pe = exp2f(S[i] - mnew); S[i] = pe; l += pe; }
#pragma unroll
            for (int s2 = 0; s2 < 2; ++s2) {
                u32x4 pw; pw.x = pk2(S[8 * s2], S[8 * s2 + 1]); pw.y = pk2(S[8 * s2 + 2], S[8 * s2 + 3]); pw.z = pk2(S[8 * s2 + 4], S[8 * s2 + 5]); pw.w = pk2(S[8 * s2 + 6], S[8 * s2 + 7]);
                const bf16x8 pb = __builtin_bit_cast(bf16x8, pw);
                const int gi = (32 * kc + 16 * s2 + 4 * hh) >> 2;
#pragma unroll
                for (int d = 0; d < 4; ++d) { const int vrow = 32 * d + r;
                    const u32x2 lo = *(const LAS u32x2*)(L + C_V + swzV(vrow, gi)), hi = *(const LAS u32x2*)(L + C_V + swzV(vrow, gi + 2));
                    u32x4 av; av.x = lo.x; av.y = lo.y; av.z = hi.x; av.w = hi.y; O[d] = MFMA32(__builtin_bit_cast(bf16x8, av), pb, O[d]); }
                asm volatile("" ::: "memory");
            }
        }
        l += __shfl_xor(l, 32);
        const float inv = frcp(l);
#pragma unroll
        for (int d = 0; d < 4; ++d)
#pragma unroll
            for (int g = 0; g < 4; ++g) { const int d0 = 32 * d + 8 * g + 4 * hh; bf16* zp = Z + (size_t)(m0 + r) * ZP + ZC_GC + h * 128 + d0;
                float gg[4]; unpack4(*(const u32x2*)zp, gg);
                u32x2 o; o.x = pk2(O[d][4 * g] * inv * gg[0], O[d][4 * g + 1] * inv * gg[1]); o.y = pk2(O[d][4 * g + 2] * inv * gg[2], O[d][4 * g + 3] * inv * gg[3]);
                bf16* op = dummy ? (bf16*)c.out + 16 * 1024 * 1024 + (size_t)(m0 + r) * 512 + h * 128 + d0 : zp;
                *(u32x2*)op = o; }
    }
    __syncthreads();
}

constexpr int N_A_P = 1024, N_B_P = 1024, N_C = 256 + 32, N_A_S = 32, N_B_S = 16;
DI void phase_p2a(Ctx& c) {
    bf16* ST = (bf16*)c.out;
    for (int it = c.bid; it < N_A_P + N_B_P + N_C; it += c.G) {
        if (it < N_A_P) { const int b = it >> 7, cc = (it >> 2) & 31, h = it & 3;
            for (int rr = 0; rr < ((PROBE_REP == 20) ? 2 : 1); ++rr) hgrn_item<1>(c, b * SEQ + 64 * cc, 64, h, nullptr, ST + (size_t)it * 16384, WSP(float, WS_DC) + it * 128, nullptr, nullptr); }
        else if (it < N_A_P + N_B_P) { const int wi = (it - N_A_P) * 8 + c.wave; for (int rr = 0; rr < ((PROBE_REP == 21) ? (int)(c.G > 0) + 1 : 1); ++rr) lru_wave_item<0>(c, wi >> 10, (wi >> 4) & 63, wi & 15); __syncthreads(); }
        else { for (int rr = 0; rr < ((PROBE_REP == 22) ? (int)(c.G > 0) + 1 : 1); ++rr) attn_item(c, it - N_A_P - N_B_P, (PROBE_REP == 22) && rr == 0); }
    }
}
template <bool DUMMY> DI void phase_p2b(Ctx& c) {
    bf16* ST = (bf16*)c.out; bf16* STW = DUMMY ? ST + 16 * 1024 * 1024 : ST;
    for (int e = c.bid * 512 + c.tid; e < 131072 + 8192; e += c.G * 512) {
        if (e < 131072) {
            const int kq = e & 31, v = (e >> 5) & 127, bh = e >> 12, b = bh >> 2, h = bh & 3;
            float s[4] = {0.f, 0.f, 0.f, 0.f};
#pragma unroll 1
            for (int c0 = 0; c0 < 32; c0 += 8) {
                u32x2 kvw[8]; f32x4 dcv[8];
#pragma unroll
                for (int q = 0; q < 8; ++q) { const int item = (b * 32 + c0 + q) * 4 + h; kvw[q] = *(const u32x2*)(ST + (size_t)item * 16384 + v * 128 + kq * 4); dcv[q] = *(const f32x4*)(WSP(float, WS_DC) + item * 128 + kq * 4); }
#pragma unroll
                for (int q = 0; q < 8; ++q) { const int item = (b * 32 + c0 + q) * 4 + h; float kv[4]; unpack4(kvw[q], kv);
                    u32x2 o; o.x = pk2(s[0], s[1]); o.y = pk2(s[2], s[3]); *(u32x2*)(STW + (size_t)item * 16384 + v * 128 + kq * 4) = o;
                    s[0] = dcv[q].x * s[0] + kv[0]; s[1] = dcv[q].y * s[1] + kv[1]; s[2] = dcv[q].z * s[2] + kv[2]; s[3] = dcv[q].w * s[3] + kv[3]; }
            }
#pragma unroll
            for (int i = 0; i < 4; ++i) c.out[O_HP + ((size_t)bh * 128 + kq * 4 + i) * 128 + v] = s[i];
        } else {
            const int e2 = e - 131072, b = e2 >> 10, ch = e2 & 1023; float carry = 0.f;
#pragma unroll 1
            for (int j0 = 0; j0 < NTT; j0 += 8) {
                f32x2 ta[8];
#pragma unroll
                for (int q = 0; q < 8; ++q) ta[q] = *(const f32x2*)(WSP(float, WS_TAGG) + ((size_t)(b * NTT + j0 + q) * 1024 + ch) * 2);
#pragma unroll
                for (int q = 0; q < 8; ++q) { WSP(float, WS_CIN)[(size_t)(b * NTT + j0 + q) * 1024 + ch] = carry; carry = ta[q].x * carry + ta[q].y; }
            }
            c.out[O_LP + b * 1024 + ch] = carry;
        }
    }
}
DI void phase_p2c(Ctx& c) {
    bf16* ST = (bf16*)c.out;
    for (int it = c.bid; it < N_A_P + N_A_S + N_B_P + N_B_S; it += c.G) {
        if (it < N_A_P) { const int b = it >> 7, cc = (it >> 2) & 31, h = it & 3;
            if (PROBE_REP == 40) hgrn_item<2>(c, b * SEQ + 64 * cc, 64, h, ST + (size_t)it * 16384, nullptr, nullptr, nullptr, nullptr, ZC_QC);
            hgrn_item<2>(c, b * SEQ + 64 * cc, 64, h, ST + (size_t)it * 16384, nullptr, nullptr, nullptr, nullptr); }
        else if (it < N_A_P + N_A_S) { const int i = it - N_A_P, b = i >> 2, h = i & 3;
            hgrn_item<3>(c, MP + b * DSEQ, 32, h, WSP(bf16, WS_ST0) + (size_t)i * 16384, nullptr, nullptr, c.in[5] + (size_t)i * 16384, c.out + O_HS + (size_t)i * 16384); }
        else if (it < N_A_P + N_A_S + N_B_P) { const int wi = (it - N_A_P - N_A_S) * 8 + c.wave; if (PROBE_REP == 41) lru_wave_item<1, true>(c, wi >> 10, (wi >> 4) & 63, wi & 15); lru_wave_item<1>(c, wi >> 10, (wi >> 4) & 63, wi & 15); __syncthreads(); }
        else { const int wi = (it - N_A_P - N_A_S - N_B_P) * 8 + c.wave; lru_wave_item<2>(c, wi >> 4, 0, wi & 15); __syncthreads(); }
    }
}

struct Args { const float* in[27]; float* out; unsigned char* ws; int ph_lo, ph_hi; };
constexpr int N_PHASES = 8;
__global__ void __launch_bounds__(512, 2) mk_fwd(Args a) {
    extern __shared__ __attribute__((aligned(16))) unsigned char lds_raw[];
    Ctx c;
    c.lds = (LAS unsigned char*)lds_raw;
    c.tid = threadIdx.x; c.lane = c.tid & 63; c.wave = __builtin_amdgcn_readfirstlane(c.tid >> 6);
    c.G = gridDim.x; c.bid = blockIdx.x;
#pragma unroll
    for (int i = 0; i < 27; ++i) c.in[i] = a.in[i];
    c.out = a.out; c.ws = a.ws;
    volatile LAS unsigned* MISC = (volatile LAS unsigned*)(c.lds + MISC_OFF);
    if (c.tid < 64) MISC[c.tid] = 0u;
    __syncthreads();
    XcdBarrier bar; bar.bar = (unsigned*)(a.ws + WS_CTL) + 1024; bar.x = 0; bar.st = nullptr;
    if (MK_N_LAUNCHES == 1) bar = xcd_barrier_post((unsigned*)(a.ws + WS_CTL) + 1024, MISC + 8);
    const int lo = a.ph_lo, hi = a.ph_hi;
#define IN(k) (lo <= (k) && (k) < hi)
#define SEAM(k) do { if (IN(k) && IN((k) + 1)) xcd_barrier(bar); } while (0)
#define REPS(k) ((PROBE_REP == (k)) ? (int)(c.G > 0) + 1 : 1)
    if (IN(0)) for (int rr = 0; rr < REPS(0); ++rr) { phase_prologue(c); if (rr + 1 < REPS(0)) xcd_barrier(bar); }
    SEAM(0);
    if (IN(1)) for (int rr = 0; rr < REPS(1); ++rr) { phase_g1(c); if (rr + 1 < REPS(1)) xcd_barrier(bar); }
    SEAM(1);
    if (IN(2)) phase_p2a(c);
    SEAM(2);
    if (PROBE_REP == 30) { phase_p2b<true>(c); xcd_barrier(bar); }
    if (IN(3)) phase_p2b<false>(c);
    SEAM(3);
    if (IN(4)) phase_p2c(c);
    SEAM(4);
    if (IN(5)) for (int rr = 0; rr < REPS(5); ++rr) { phase_g3(c); if (rr + 1 < REPS(5)) xcd_barrier(bar); }
    SEAM(5);
    if (IN(6)) for (int rr = 0; rr < REPS(6); ++rr) { phase_g4(c); if (rr + 1 < REPS(6)) xcd_barrier(bar); }
    SEAM(6);
    if (PROBE_REP == 80) for (int rr = 0; rr < 10; ++rr) xcd_barrier(bar);
    if (PROBE_REP == 70) { phase_final<true>(c); xcd_barrier(bar); }
    if (IN(7)) phase_final<false>(c);
#undef IN
#undef SEAM
}

extern "C" void kernel_launch(void* const* d_in, const int* in_sizes, int n_in, void* d_out, int out_size, void* d_ws, size_t ws_size, hipStream_t stream) {
    static int grid = 0;
    if (grid == 0) {
        if (n_in != 27 || ws_size < WS_END) { fprintf(stderr, "kernel_launch: unexpected n_in %d / ws_size %zu (need %zu)\n", n_in, ws_size, (size_t)WS_END); grid = -1; return; }
        int dev = 0, cus = 0, per_cu = 0;
        if (hipGetDevice(&dev) != hipSuccess || hipDeviceGetAttribute(&cus, hipDeviceAttributeMultiprocessorCount, dev) != hipSuccess) { grid = -1; return; }
        if (hipFuncSetAttribute((const void*)mk_fwd, hipFuncAttributeMaxDynamicSharedMemorySize, LDS_BYTES) != hipSuccess) { fprintf(stderr, "kernel_launch: hipFuncSetAttribute failed\n"); grid = -1; return; }
        if (hipOccupancyMaxActiveBlocksPerMultiprocessor(&per_cu, (const void*)mk_fwd, 512, LDS_BYTES) != hipSuccess || per_cu < 1) { fprintf(stderr, "kernel_launch: occupancy query says %d\n", per_cu); per_cu = 1; }
        (void)hipGetLastError();
        grid = cus;
    }
    if (grid < 0) return;
    (void)hipMemsetAsync((char*)d_ws + WS_CTL, 0, CTL_ZERO_BYTES, stream);
    Args a{};
    for (int i = 0; i < 27; ++i) a.in[i] = (const float*)d_in[i];
    a.out = (float*)d_out; a.ws = (unsigned char*)d_ws;
    if (MK_N_LAUNCHES == 1) {
        a.ph_lo = 0; a.ph_hi = N_PHASES;
        hipLaunchKernelGGL(mk_fwd, dim3(grid), dim3(512), LDS_BYTES, stream, a);
    } else {
        for (int p = 0; p < N_PHASES; ++p) { a.ph_lo = p; a.ph_hi = p + 1; hipLaunchKernelGGL(mk_fwd, dim3(grid), dim3(512), LDS_BYTES, stream, a); }
    }
}
```

```cpp
#include <hip/hip_runtime.h>
#include <cstdio>
#include <cstdint>

#ifndef MK_N_LAUNCHES
#define MK_N_LAUNCHES 1
#endif

#define PROBE_REP -1
#define DI __device__ __forceinline__
#define LAS __attribute__((address_space(3)))
typedef unsigned short bf16;
typedef short bf16x8 __attribute__((ext_vector_type(8)));
typedef float f32x16 __attribute__((ext_vector_type(16)));
typedef float f32x4 __attribute__((ext_vector_type(4)));
typedef float f32x2 __attribute__((ext_vector_type(2)));
typedef unsigned u32x4 __attribute__((ext_vector_type(4)));
typedef unsigned u32x2 __attribute__((ext_vector_type(2)));
typedef __bf16 bf16x2_t __attribute__((ext_vector_type(2)));

constexpr int DM = 1024, NB = 8, SEQ = 2048, DSEQ = 32, NMEM = 256;
constexpr int MP = NB * SEQ, MS = NB * DSEQ, MT = MP + MS;
constexpr int ZP = 5120;
constexpr int ZC_QA = 0, ZC_FA = 512, ZC_VA = 1024, ZC_GA = 1536, ZC_XB = 2048, ZC_GB = 3072, ZC_QC = 4096, ZC_GC = 4608;
constexpr int ZC_MG = 0;
constexpr float EPS = 1e-6f;
constexpr float QSCALE = 0.08838834764831845f * 1.4426950408889634f;

constexpr size_t O_YP = 0, O_YS = 16777216, O_HP = 17039360, O_CP = 17563648, O_LP = 17588224, O_MK = 17596416, O_MV = 18644992,
                 O_HS = 19693568, O_CS = 20217856, O_LS = 20242432;

constexpr size_t MiB = 1u << 20;
constexpr size_t WS_CTL = 0, CTL_ZERO_BYTES = 64 * 1024;
constexpr size_t WS_LB = 128 * 1024;
constexpr size_t WS_WIN = 1 * MiB, WS_WA = 17 * MiB, WS_WB = 19 * MiB, WS_WC = 21 * MiB, WS_WOUT = 23 * MiB, WS_WMEM = 25 * MiB,
                 WS_WLRU = 27 * MiB, WS_TAGG = 28 * MiB, WS_CIN = 32 * MiB, WS_DC = 34 * MiB, WS_ST0 = 35 * MiB, WS_KBP = 36 * MiB,
                 WS_VTP = 38 * MiB, WS_KBS = 40 * MiB, WS_VTS = 42 * MiB, WS_HM = 44 * MiB, WS_H = 48 * MiB, WS_Z = 81 * MiB;
constexpr size_t WS_ZGS = 244 * MiB, WS_PS = 246 * MiB;
constexpr size_t WS_END = 248 * MiB;
static_assert(WS_Z + (size_t)MT * ZP * 2 <= WS_ZGS, "ws map (Z)");
static_assert(WS_H + (size_t)MT * DM * 2 <= WS_Z && WS_END <= 256 * MiB, "ws map");

constexpr int LDS_BYTES = 147456;
constexpr int MISC_OFF = 131072;

DI float bf2f(unsigned short b) { return __uint_as_float((unsigned)b << 16); }
DI unsigned pk2(float lo, float hi) { f32x2 v = {lo, hi}; bf16x2_t b = __builtin_convertvector(v, bf16x2_t); return __builtin_bit_cast(unsigned, b); }
DI float frcp(float x) { return __builtin_amdgcn_rcpf(x); }
DI float sigm(float x) { return frcp(1.0f + __expf(-x)); }
DI float silu(float x) { return x * sigm(x); }
DI void unpack8(const u32x4 w, float (&f)[8]) {
    f[0] = __uint_as_float(w.x << 16); f[1] = __uint_as_float(w.x & 0xffff0000u);
    f[2] = __uint_as_float(w.y << 16); f[3] = __uint_as_float(w.y & 0xffff0000u);
    f[4] = __uint_as_float(w.z << 16); f[5] = __uint_as_float(w.z & 0xffff0000u);
    f[6] = __uint_as_float(w.w << 16); f[7] = __uint_as_float(w.w & 0xffff0000u);
}
DI void unpack4(const u32x2 w, float (&f)[4]) {
    f[0] = __uint_as_float(w.x << 16); f[1] = __uint_as_float(w.x & 0xffff0000u);
    f[2] = __uint_as_float(w.y << 16); f[3] = __uint_as_float(w.y & 0xffff0000u);
}
DI int crow(int reg, int h) { return (reg & 3) + 8 * (reg >> 2) + 4 * h; }
#define MFMA32(a, b, c) __builtin_amdgcn_mfma_f32_32x32x16_bf16((a), (b), (c), 0, 0, 0)
DI float wave_sum(float v) {
#pragma unroll
    for (int o = 1; o < 64; o <<= 1) v += __shfl_xor(v, o);
    return v;
}

struct Ctx {
    LAS unsigned char* lds;
    int tid, lane, wave, G, bid;
    const float* in[27];
    float* out;
    unsigned char* ws;
};
#define WSP(T, off) ((T*)(c.ws + (off)))

#define XB_TMO      128
#define XB_XCNT(j)  (256  + 64 * (j))
#define XB_XSUB(j)  (1280 + 64 * (j))
#define XB_XGEN(j)  (2304 + 64 * (j))
#define XB_TOP      3328
#define XB_TOPGEN   3392
#define XCD_BAR_WORDS 3456
#define XB_SPIN_CAP (1u << 18)
DI unsigned xb_ld(unsigned* p)              { return __hip_atomic_load(p, __ATOMIC_RELAXED, __HIP_MEMORY_SCOPE_AGENT); }
DI unsigned xb_add(unsigned* p, unsigned v) { return __hip_atomic_fetch_add(p, v, __ATOMIC_RELAXED, __HIP_MEMORY_SCOPE_AGENT); }
DI unsigned xb_xcc_id() { return (unsigned)__builtin_amdgcn_s_getreg((3 << 11) | 20) & 0xFu; }
#define XB_SPIN(cond, bar) do { unsigned _sp = 0; while (cond) { __builtin_amdgcn_s_sleep(1); \
    if ((++_sp & 255u) == 0u) { if (xb_ld(&(bar)[XB_TMO])) break; if (_sp > XB_SPIN_CAP) { atomicAdd(&(bar)[XB_TMO], 1u); break; } } } } while (0)
struct XcdBarrier { unsigned* bar; unsigned x; volatile LAS unsigned* st; };
DI XcdBarrier xcd_barrier_post(unsigned* bar, volatile LAS unsigned* st) {
    XcdBarrier b; b.bar = bar; b.x = xb_xcc_id(); b.st = st;
    if (threadIdx.x == 0) (void)xb_add(&bar[XB_XCNT(b.x)], 1u);
    return b;
}
DI void xcd_barrier_complete(unsigned* bar, unsigned x, unsigned& nloc, unsigned& nx) {
    const unsigned G = gridDim.x * gridDim.y * gridDim.z;
    unsigned sum, cnt, mine, sp = 0u;
    for (;;) {
        sum = 0u; cnt = 0u; mine = 0u;
#pragma unroll
        for (unsigned j = 0; j < 16; ++j) { const unsigned c = xb_ld(&bar[XB_XCNT(j)]); sum += c; cnt += (c > 0u) ? 1u : 0u; mine = (j == x) ? c : mine; }
        if (sum == G) break;
        __builtin_amdgcn_s_sleep(1);
        if ((++sp & 255u) == 0u) { if (xb_ld(&bar[XB_TMO])) break; if (sp > XB_SPIN_CAP) { atomicAdd(&bar[XB_TMO], 1u); break; } }
    }
    nloc = mine > 0u ? mine : 1u; nx = cnt > 0u ? cnt : 1u;
}
DI void xcd_barrier(const XcdBarrier& b) {
    asm volatile("s_waitcnt vmcnt(0)" ::: "memory");
    __syncthreads();
    if (threadIdx.x == 0) {
        unsigned* bar = b.bar;
        __builtin_amdgcn_s_waitcnt(0);
        unsigned nloc = b.st[0], nx = b.st[1];
        if (nloc == 0u) { xcd_barrier_complete(bar, b.x, nloc, nx); b.st[0] = nloc; b.st[1] = nx; }
        const unsigned old = xb_add(&bar[XB_XSUB(b.x)], 1u);
        const unsigned gen = old / nloc;
        if (old + 1u == (gen + 1u) * nloc) {
            __builtin_amdgcn_fence(__ATOMIC_RELEASE, "agent");
            asm volatile("s_waitcnt vmcnt(0)" ::: "memory");
            const unsigned og = xb_add(&bar[XB_TOP], 1u);
            const unsigned tg = og / nx;
            if (og + 1u == (tg + 1u) * nx) xb_add(&bar[XB_TOPGEN], 1u);
            else XB_SPIN(xb_ld(&bar[XB_TOPGEN]) == tg, bar);
            __builtin_amdgcn_fence(__ATOMIC_ACQUIRE, "agent");
            xb_add(&bar[XB_XGEN(b.x)], 1u);
            asm volatile("s_waitcnt vmcnt(0)" ::: "memory");
        } else {
            XB_SPIN(xb_ld(&bar[XB_XGEN(b.x)]) == gen, bar);
            __builtin_amdgcn_fence(__ATOMIC_ACQUIRE, "agent");
            asm volatile("s_waitcnt vmcnt(0)" ::: "memory");
        }
    }
    __syncthreads();
}

DI void p0_transpose_item(const float* W, int K, int N, bf16* WT, int ldt, int row_off, LAS float* scr, int item, int lane) {
    const int nblk = N / 32, kb = item / nblk, nb = item % nblk, k0 = 64 * kb, n0 = 32 * nb;
#pragma unroll 8
    for (int i = 0; i < 32; ++i) { const int kk = 2 * i + (lane >> 5); scr[kk * 33 + (lane & 31)] = W[(size_t)(k0 + kk) * N + n0 + (lane & 31)]; }
    asm volatile("s_waitcnt lgkmcnt(0)" ::: "memory");
    const int cc = lane & 7;
#pragma unroll
    for (int j = 0; j < 4; ++j) { const int n = (lane >> 3) + 8 * j; const LAS float* s = scr + (8 * cc) * 33 + n;
        u32x4 o; o.x = pk2(s[0 * 33], s[1 * 33]); o.y = pk2(s[2 * 33], s[3 * 33]); o.z = pk2(s[4 * 33], s[5 * 33]); o.w = pk2(s[6 * 33], s[7 * 33]);
        *(u32x4*)(WT + (size_t)(row_off + n0 + n) * ldt + k0 + 8 * cc) = o; }
    asm volatile("s_waitcnt lgkmcnt(0)" ::: "memory");
}
DI void rms_row_to_bf16(const float* xrow, const float* g, bf16* orow, int lane) {
    const f32x4* xr = (const f32x4*)xrow + lane; const f32x4* gr = (const f32x4*)g + lane;
    f32x4 v[4]; float s = 0.f;
#pragma unroll
    for (int j = 0; j < 4; ++j) { v[j] = xr[64 * j]; s += (v[j].x * v[j].x + v[j].y * v[j].y) + (v[j].z * v[j].z + v[j].w * v[j].w); }
    const float rs = __builtin_amdgcn_rsqf(wave_sum(s) * (1.f / DM) + EPS);
    u32x2* o8 = (u32x2*)orow + lane;
#pragma unroll
    for (int j = 0; j < 4; ++j) { const f32x4 gg = gr[64 * j]; u32x2 w; w.x = pk2(v[j].x * rs * gg.x, v[j].y * rs * gg.y); w.y = pk2(v[j].z * rs * gg.z, v[j].w * rs * gg.w); o8[64 * j] = w; }
}
DI void phase_prologue(Ctx& c) {
    LAS float* scr = (LAS float*)(c.lds + c.wave * 16384);
    const int gw = c.bid * 8 + c.wave, NGW = c.G * 8;
    constexpr int I_WIN = 16 * 256, I_WA = 8 * 32, I_WB = 16 * 32, I_WC = 8 * 32, I_WO = 16 * 32, I_MK = 16 * 16, I_MV = 16 * 16, I_LR = 32, I_LI = 32, I_ST = 32 * 8, I_VS = 8 * 64;
    constexpr int NITEMS = I_WIN + I_WA + I_WB + I_WC + I_WO + I_MK + I_MV + I_LR + I_LI + I_ST + I_VS;
    for (int it = gw; it < NITEMS; it += NGW) {
        int r = it;
        if (r < I_WIN) { p0_transpose_item(c.in[9], 1024, 8192, WSP(bf16, WS_WIN), 1024, 0, scr, r, c.lane); continue; } r -= I_WIN;
        if (r < I_WA) { p0_transpose_item(c.in[12], 512, 1024, WSP(bf16, WS_WA), 1024, 0, scr, r, c.lane); continue; } r -= I_WA;
        if (r < I_WB) { p0_transpose_item(c.in[20], 1024, 1024, WSP(bf16, WS_WB), 1024, 0, scr, r, c.lane); continue; } r -= I_WB;
        if (r < I_WC) { p0_transpose_item(c.in[24], 512, 1024, WSP(bf16, WS_WC), 1024, 0, scr, r, c.lane); continue; } r -= I_WC;
        if (r < I_WO) { p0_transpose_item(c.in[25], 1024, 1024, WSP(bf16, WS_WOUT), 1024, 0, scr, r, c.lane); continue; } r -= I_WO;
        if (r < I_MK) { p0_transpose_item(c.in[22], 1024, 512, WSP(bf16, WS_WMEM), 1024, 0, scr, r, c.lane); continue; } r -= I_MK;
        if (r < I_MV) { p0_transpose_item(c.in[23], 1024, 512, WSP(bf16, WS_WMEM), 1024, 512, scr, r, c.lane); continue; } r -= I_MV;
        if (r < I_LR) { const int n = r >> 1; p0_transpose_item(c.in[15] + n * 4096, 64, 64, WSP(bf16, WS_WLRU) + n * 4096, 64, 0, scr, r & 1, c.lane); continue; } r -= I_LR;
        if (r < I_LI) { const int n = r >> 1; p0_transpose_item(c.in[17] + n * 4096, 64, 64, WSP(bf16, WS_WLRU) + 65536 + n * 4096, 64, 0, scr, r & 1, c.lane); continue; } r -= I_LI;
        if (r < I_ST) { const int bh = r >> 3; p0_transpose_item(c.in[5] + (size_t)bh * 16384, 128, 128, WSP(bf16, WS_ST0) + (size_t)bh * 16384, 128, 0, scr, r & 7, c.lane); continue; } r -= I_ST;
        { const int b = r >> 6; p0_transpose_item(c.in[4] + (size_t)b * 131072, 256, 512, WSP(bf16, WS_VTS) + (size_t)b * 131072, 256, 0, scr, r & 63, c.lane); }
    }
    for (int m = gw; m < MT + NB * NMEM; m += NGW) {
        if (m < MP) rms_row_to_bf16(c.in[0] + (size_t)m * DM, c.in[8], WSP(bf16, WS_H) + (size_t)m * DM, c.lane);
        else if (m < MT) rms_row_to_bf16(c.in[1] + (size_t)(m - MP) * DM, c.in[8], WSP(bf16, WS_H) + (size_t)m * DM, c.lane);
        else rms_row_to_bf16(c.in[2] + (size_t)(m - MT) * DM, c.in[21], WSP(bf16, WS_HM) + (size_t)(m - MT) * DM, c.lane);
    }
    if (c.bid == 0) { const float* lbl = c.in[10]; WSP(float, WS_LB)[c.tid] = frcp(1.0f + __expf(lbl[512 + c.tid] - lbl[c.tid])); }
    { const size_t n8 = (size_t)NB * NMEM * 512 / 8; const f32x4* src = (const f32x4*)c.in[3]; u32x4* dst = WSP(u32x4, WS_KBS);
      for (size_t i = (size_t)c.bid * 512 + c.tid; i < n8; i += (size_t)c.G * 512) { const f32x4 a = src[2 * i], b = src[2 * i + 1]; u32x4 o; o.x = pk2(a.x, a.y); o.y = pk2(a.z, a.w); o.z = pk2(b.x, b.y); o.w = pk2(b.z, b.w); dst[i] = o; } }
}

DI int swz256(int row, int chunk) { return row * 256 + ((chunk ^ (row & 15)) << 4); }
DI int swz128(int row, int chunk) { return row * 128 + ((chunk ^ ((row >> 1) & 7)) << 4); }
DI u32x4 add3_bf16x8(const u32x4 x, const u32x4 y, const u32x4 z) { float a[8], b[8], d[8]; unpack8(x, a); unpack8(y, b); unpack8(z, d);
    u32x4 o; o.x = pk2(a[0] + b[0] + d[0], a[1] + b[1] + d[1]); o.y = pk2(a[2] + b[2] + d[2], a[3] + b[3] + d[3]); o.z = pk2(a[4] + b[4] + d[4], a[5] + b[5] + d[5]); o.w = pk2(a[6] + b[6] + d[6], a[7] + b[7] + d[7]); return o; }
template <bool SUM3 = false>
DI void gemm_kloop(Ctx& c, f32x16 (&acc)[2], const bf16* A, int lda, const bf16* Bt, int ldb, int K, int m0, int n0, size_t a_stride = 0) {
    const int tid = c.tid, lane = c.lane, w = c.wave, wr = w >> 1, wc = w & 1, r = lane & 31, h = lane >> 5;
    const int srow = tid >> 2, scp = tid & 3;
    const bf16* ga = A + (size_t)(m0 + srow) * lda + scp * 16;
    const bf16* gb = Bt + (size_t)(n0 + srow) * ldb + scp * 16;
    const int wo0 = swz128(srow, 2 * scp), wo1 = swz128(srow, 2 * scp + 1);
    const int nk = K / 64;
    u32x4 p0, p1, p2, p3, q0, q1, q2, q3;
#define GK_LOAD(x0, x1, x2, x3, kt) do { const bf16* pa_ = ga + (kt) * 64; const bf16* pb_ = gb + (kt) * 64; \
        if (SUM3) { x0 = add3_bf16x8(*(const u32x4*)(pa_), *(const u32x4*)(pa_ + a_stride), *(const u32x4*)(pa_ + 2 * a_stride)); \
                    x1 = add3_bf16x8(*(const u32x4*)(pa_ + 8), *(const u32x4*)(pa_ + 8 + a_stride), *(const u32x4*)(pa_ + 8 + 2 * a_stride)); } \
        else { x0 = *(const u32x4*)(pa_); x1 = *(const u32x4*)(pa_ + 8); } \
        x2 = *(const u32x4*)(pb_); x3 = *(const u32x4*)(pb_ + 8); } while (0)
#define GK_STORE(x0, x1, x2, x3, off) do { *(LAS u32x4*)(c.lds + (off) + wo0) = x0; *(LAS u32x4*)(c.lds + (off) + wo1) = x1; *(LAS u32x4*)(c.lds + (off) + 16384 + wo0) = x2; *(LAS u32x4*)(c.lds + (off) + 16384 + wo1) = x3; } while (0)
#define GK_COMPUTE(cur) do { _Pragma("unroll") for (int s_ = 0; s_ < 4; ++s_) { const bf16x8 af = *(const LAS bf16x8*)(c.lds + (cur) + swz128(32 * wr + r, 2 * s_ + h)); \
        _Pragma("unroll") for (int j_ = 0; j_ < 2; ++j_) { const bf16x8 bfr = *(const LAS bf16x8*)(c.lds + (cur) + 16384 + swz128(64 * wc + 32 * j_ + r, 2 * s_ + h)); acc[j_] = MFMA32(bfr, af, acc[j_]); } } } while (0)
    GK_LOAD(p0, p1, p2, p3, 0); GK_LOAD(q0, q1, q2, q3, 1);
    __syncthreads();
    GK_STORE(p0, p1, p2, p3, 0);
    __syncthreads();
    for (int kt = 0; kt < nk; kt += 2) {
        if (kt + 2 < nk) GK_LOAD(p0, p1, p2, p3, kt + 2);
        GK_COMPUTE(0);
        GK_STORE(q0, q1, q2, q3, 32768);
        __syncthreads();
        if (kt + 3 < nk) GK_LOAD(q0, q1, q2, q3, kt + 3);
        GK_COMPUTE(32768);
        if (kt + 2 < nk) GK_STORE(p0, p1, p2, p3, 0);
        __syncthreads();
    }
#undef GK_LOAD
#undef GK_STORE
#undef GK_COMPUTE
}
template <class Epi> DI void gemm_epi(Ctx& c, const f32x16 (&acc)[2], int m0, int n0, const Epi& E) {
    const int lane = c.lane, w = c.wave, wr = w >> 1, wc = w & 1, r = lane & 31, h = lane >> 5;
    const int m = m0 + 32 * wr + r;
#pragma unroll
    for (int j = 0; j < 2; ++j)
#pragma unroll
        for (int g = 0; g < 4; ++g) { const int n = n0 + 64 * wc + 32 * j + 8 * g + 4 * h; E(m, n, (f32x4){acc[j][4 * g], acc[j][4 * g + 1], acc[j][4 * g + 2], acc[j][4 * g + 3]}); }
}
template <class Epi> DI void gemm_tile(Ctx& c, const bf16* A, int lda, const bf16* Bt, int ldb, int K, int m0, int n0, const Epi& E) {
    f32x16 acc[2];
#pragma unroll
    for (int j = 0; j < 2; ++j)
#pragma unroll
        for (int i = 0; i < 16; ++i) acc[j][i] = 0.f;
    gemm_kloop(c, acc, A, lda, Bt, ldb, K, m0, n0);
    gemm_epi(c, acc, m0, n0, E);
}

struct EpiZ {
    bf16* Z; float* out;
    DI void operator()(int m, int n, f32x4 v) const {
        if (n >= ZC_XB && n < ZC_GB) {
            int b, t3;
            if (m < MP) { b = m >> 11; t3 = (m & 2047) - 2045; } else { b = (m - MP) >> 5; t3 = ((m - MP) & 31) - 29; }
            if (t3 >= 0) { float* o = out + (m < MP ? O_CP : O_CS) + (size_t)(b * 3 + t3) * 1024 + (n - ZC_XB); *(f32x4*)o = v; }
        }
        const bool act = (n < ZC_FA) || (n >= ZC_GA && n < ZC_XB) || (n >= ZC_GB && n < ZC_QC) || (n >= ZC_GC);
        if (act) { v.x = silu(v.x); v.y = silu(v.y); v.z = silu(v.z); v.w = silu(v.w); }
        if (n >= ZC_QC && n < ZC_GC) { v = v * QSCALE; }
        u32x2 o; o.x = pk2(v.x, v.y); o.y = pk2(v.z, v.w);
        *(u32x2*)(Z + (size_t)m * ZP + n) = o;
    }
};
struct EpiMK {
    bf16* KB; float* out;
    DI void operator()(int m, int n, f32x4 v) const {
        *(f32x4*)(out + O_MK + (size_t)m * 512 + n) = v;
        u32x2 o; o.x = pk2(v.x, v.y); o.y = pk2(v.z, v.w); *(u32x2*)(KB + (size_t)m * 512 + n) = o;
    }
};
struct EpiMV {
    bf16* VT; float* out;
    DI void operator()(int nn, int m, f32x4 v) const {
        float* o = out + O_MV + (size_t)m * 512 + nn; o[0] = v.x; o[512] = v.y; o[1024] = v.z; o[1536] = v.w;
        const int b = m >> 8; u32x2 p; p.x = pk2(v.x, v.y); p.y = pk2(v.z, v.w);
        *(u32x2*)(VT + ((size_t)b * 512 + nn) * 256 + (m & 255)) = p;
    }
};
struct EpiZGS { bf16* G; DI void operator()(int m, int n, f32x4 v) const { u32x2 o; o.x = pk2(sigm(v.x), sigm(v.y)); o.y = pk2(sigm(v.z), sigm(v.w)); *(u32x2*)(G + (size_t)(m - MP) * 3072 + n) = o; } };
struct EpiPS { const bf16* G; bf16* P; int br;
    DI void operator()(int m, int n, f32x4 v) const { float g[4]; unpack4(*(const u32x2*)(G + (size_t)(m - MP) * 3072 + 1024 * br + n), g);
        u32x2 o; o.x = pk2(g[0] * v.x, g[1] * v.y); o.y = pk2(g[2] * v.z, g[3] * v.w); *(u32x2*)(P + ((size_t)br * MS + (m - MP)) * DM + n) = o; } };
struct EpiYS { const float* xs; float* out;
    DI void operator()(int m, int n, f32x4 v) const { const f32x4 xv = *(const f32x4*)(xs + (size_t)m * DM + n); *(f32x4*)(out + O_YS + (size_t)m * DM + n) = xv + v; } };
struct EpiMG { bf16* Z; DI void operator()(int m, int n, f32x4 v) const { u32x2 o; o.x = pk2(v.x, v.y); o.y = pk2(v.z, v.w); *(u32x2*)(Z + (size_t)m * ZP + ZC_MG + n) = o; } };
struct EpiY {
    const float* xp; const float* xs; float* out;
    DI void operator()(int m, int n, f32x4 v) const {
        const float* x = (m < MP) ? xp + (size_t)m * DM + n : xs + (size_t)(m - MP) * DM + n;
        const f32x4 xv = *(const f32x4*)x;
        *(f32x4*)(out + (size_t)m * DM + n) = xv + v;
    }
};


namespace pgx {
constexpr int BM = 256, BK = 64, HALF = 128, HTB = HALF * BK * 2, STAGE_BYTES = 8 * HTB, NXCD = 8, WGM = 8;
DI int lds_byte(int r, int c) { const int st = (r >> 4) * 2 + (c >> 5), rr = r & 15, cc = c & 31, ob = rr * 64 + cc * 2; return st * 1024 + (ob ^ (((ob >> 9) & 1) << 5)); }
DI void stage_rc(int b, int& R, int& C) { const int st = b / 1024, sb = b % 1024, swz = sb ^ (((sb >> 9) & 1) << 5); R = (st >> 1) * 16 + swz / 64; C = (st & 1) * 32 + (swz % 64) / 2; }
DI int perm32(int rho) { const int n = rho >> 4, i = rho & 15; return 8 * (i >> 2) + 4 * n + (i & 3); }
struct Unit { const char* A; const char* B; int nt, pm, pn, seg, za; };
DI bool static_tile(int i, int G, int c, int nM, int nN, int& pm, int& pn) {
    const int nwg = nM * nN; const long L = (long)i * G + c; if (L >= nwg) return false;
    int wgid = (int)L; { const int q = nwg / NXCD, r = nwg % NXCD, xcd = wgid % NXCD, off = wgid / NXCD; wgid = (xcd < r ? xcd * (q + 1) : r * (q + 1) + (xcd - r) * q) + off; }
    const int nig = WGM * nN, gid = wgid / nig, fm = gid * WGM, gsz = (nM - fm) < WGM ? (nM - fm) : WGM;
    pm = fm + ((wgid % nig) % gsz); pn = (wgid % nig) / gsz; return true;
}
template <class Epi, class Sched>
DI void gemm_phase(LAS unsigned char* lds, const int lda0, const int lda1, const int ldb, const Sched& S, Epi& E) {
    const int tid = threadIdx.x, wid = __builtin_amdgcn_readfirstlane(tid >> 6), lane = tid & 63, wr = wid >> 2, wc = wid & 3, fr = lane & 15, fq = lane >> 4;
    unsigned vA0[2], vA1[2], voffB[2];
#pragma unroll
    for (int i = 0; i < 2; ++i) { int R, C; stage_rc(tid * 16 + i * 8192, R, C); const int Rb = Epi::PERM ? ((R & ~31) + perm32(R & 31)) : R;
        vA0[i] = (unsigned)(R * lda0 + C) * 2u; vA1[i] = (unsigned)(R * lda1 + C) * 2u; voffB[i] = (unsigned)(Rb * ldb + C) * 2u; }
    const size_t kstep = (size_t)(BK * 2);
    const size_t hsA0 = (size_t)HALF * lda0 * 2, hsA1 = (size_t)HALF * lda1 * 2, hstepB = (size_t)HALF * ldb * 2;
    const unsigned ldsw = (unsigned)wid * 1024u;
    const int aoff = lds_byte(wr * 64 + fr, fq * 8), boff = lds_byte(wc * 32 + fr, fq * 8);
#define PG8_SA(b, h) (((b) * 2 + (h)) * HTB)
#define PG8_SB(b, h) ((4 + (b) * 2 + (h)) * HTB)
#define PG8_STAGE(bufoff, gbase, voff) do { _Pragma("unroll") for (int _i = 0; _i < 2; ++_i) \
        __builtin_amdgcn_global_load_lds((const unsigned*)((const char*)(gbase) + (voff)[_i]), (LAS unsigned*)(lds + (bufoff) + ldsw + _i * 8192), 16, 0, 0); } while (0)
#define PG8_LDA(dst, b, h) do { _Pragma("unroll") for (int m = 0; m < 4; ++m) _Pragma("unroll") for (int k = 0; k < 2; ++k) dst[m][k] = *(const LAS bf16x8*)(lds + PG8_SA(b, h) + aoff + m * 2048 + k * 1024); } while (0)
#define PG8_LDB(dst, b, h) do { _Pragma("unroll") for (int n = 0; n < 2; ++n) _Pragma("unroll") for (int k = 0; k < 2; ++k) dst[n][k] = *(const LAS bf16x8*)(lds + PG8_SB(b, h) + boff + n * 2048 + k * 1024); } while (0)
#define PG8_MMA(ai, bj, At, Bt) do { __builtin_amdgcn_s_setprio(1); _Pragma("unroll") for (int m = 0; m < 4; ++m) _Pragma("unroll") for (int n = 0; n < 2; ++n) _Pragma("unroll") for (int k = 0; k < 2; ++k) \
        acc[ai][bj][m][n] = __builtin_amdgcn_mfma_f32_16x16x32_bf16(Bt[n][k], At[m][k], acc[ai][bj][m][n], 0, 0, 0); __builtin_amdgcn_s_setprio(0); } while (0)
#define PG8_WAIT_V(n) asm volatile("s_waitcnt vmcnt(" #n ")" ::: "memory")
#define PG8_WAIT_L(n) asm volatile("s_waitcnt lgkmcnt(" #n ")" ::: "memory")
#define PG8_BAR __builtin_amdgcn_s_barrier()
#define PG8_SCHED __builtin_amdgcn_sched_barrier(0)
    Unit cur, nxt; int ui = 0;
    if (!S.next(0, cur)) return;
    f32x4 acc[2][2][4][2];
#pragma unroll
    for (int a = 0; a < 2; ++a)
#pragma unroll
        for (int b = 0; b < 2; ++b)
#pragma unroll
            for (int m = 0; m < 4; ++m)
#pragma unroll
                for (int n = 0; n < 2; ++n) acc[a][b][m][n] = (f32x4){0.f, 0.f, 0.f, 0.f};
    bf16x8 At[4][2], B0[2][2], B1[2][2];
    const char* cA = cur.A; const char* cB = cur.B;
    unsigned voffA[2]; voffA[0] = cur.za ? vA1[0] : vA0[0]; voffA[1] = cur.za ? vA1[1] : vA0[1];
    size_t hstepA = cur.za ? hsA1 : hsA0;
    PG8_STAGE(PG8_SB(0, 0), cB, voffB); PG8_STAGE(PG8_SB(0, 1), cB + hstepB, voffB); PG8_STAGE(PG8_SA(0, 0), cA, voffA); PG8_STAGE(PG8_SA(0, 1), cA + hstepA, voffA);
    if (wr == 1) PG8_BAR;
    PG8_WAIT_V(2); PG8_BAR;
    PG8_STAGE(PG8_SB(1, 0), cB + kstep, voffB); PG8_STAGE(PG8_SA(1, 0), cA + kstep, voffA); PG8_STAGE(PG8_SB(1, 1), cB + hstepB + kstep, voffB);
    PG8_WAIT_V(6); PG8_BAR;
    for (;;) {
        const bool has_next = S.next(ui + 1, nxt);
        const char* nA = has_next ? nxt.A : cA; const char* nB = has_next ? nxt.B : cB;
        const int nt = cur.nt;
        const bool nza = has_next ? (nxt.za != 0) : (cur.za != 0);
        for (int t = 0; t < nt; t += 2) {
            const bool last = (t == nt - 2);
            unsigned voffN[2]; voffN[0] = last ? (nza ? vA1[0] : vA0[0]) : voffA[0]; voffN[1] = last ? (nza ? vA1[1] : vA0[1]) : voffA[1];
            const size_t hstepN = last ? (nza ? hsA1 : hsA0) : hstepA;
            const char* a1 = cA + (size_t)(t + 1) * kstep;
            const char* a2 = last ? nA : cA + (size_t)(t + 2) * kstep; const char* b2 = last ? nB : cB + (size_t)(t + 2) * kstep;
            const char* a3 = a2 + kstep; const char* b3 = b2 + kstep;
            PG8_LDB(B0, 0, 0); PG8_LDB(B1, 0, 1); PG8_SCHED; PG8_LDA(At, 0, 0); PG8_STAGE(PG8_SA(1, 1), a1 + hstepA, voffA);
            PG8_WAIT_V(8); PG8_WAIT_L(0); PG8_BAR; PG8_MMA(0, 0, At, B0); PG8_MMA(0, 1, At, B1); PG8_BAR; PG8_SCHED;
            PG8_LDA(At, 0, 1); PG8_STAGE(PG8_SB(0, 0), b2, voffB); PG8_STAGE(PG8_SB(0, 1), b2 + hstepB, voffB); PG8_STAGE(PG8_SA(0, 0), a2, voffN);
            PG8_WAIT_V(8); PG8_WAIT_L(0); PG8_BAR; PG8_MMA(1, 0, At, B0); PG8_MMA(1, 1, At, B1); PG8_BAR; PG8_SCHED;
            PG8_LDB(B0, 1, 0); PG8_LDB(B1, 1, 1); PG8_SCHED; PG8_LDA(At, 1, 0); PG8_STAGE(PG8_SA(0, 1), a2 + hstepN, voffN);
            PG8_WAIT_V(8); PG8_WAIT_L(0); PG8_BAR; PG8_MMA(0, 0, At, B0); PG8_MMA(0, 1, At, B1); PG8_BAR; PG8_SCHED;
            PG8_LDA(At, 1, 1); PG8_STAGE(PG8_SB(1, 0), b3, voffB); PG8_STAGE(PG8_SB(1, 1), b3 + hstepB, voffB); PG8_STAGE(PG8_SA(1, 0), a3, voffN);
            PG8_WAIT_V(8); PG8_WAIT_L(0); PG8_BAR; PG8_MMA(1, 0, At, B0); PG8_MMA(1, 1, At, B1); PG8_BAR; PG8_SCHED;
        }
        if (wr == 0) PG8_BAR;
        E(acc, cur, wr, wc, fr, fq);
        if (!has_next) break;
#pragma unroll
        for (int a = 0; a < 2; ++a)
#pragma unroll
            for (int b = 0; b < 2; ++b)
#pragma unroll
                for (int m = 0; m < 4; ++m)
#pragma unroll
                    for (int n = 0; n < 2; ++n) acc[a][b][m][n] = (f32x4){0.f, 0.f, 0.f, 0.f};
        cur = nxt; cA = nA; cB = nB; ++ui;
        voffA[0] = cur.za ? vA1[0] : vA0[0]; voffA[1] = cur.za ? vA1[1] : vA0[1]; hstepA = cur.za ? hsA1 : hsA0;
        if (wr == 1) PG8_BAR;
    }
    PG8_WAIT_V(0);
    PG8_BAR;
#undef PG8_SA
#undef PG8_SB
#undef PG8_STAGE
#undef PG8_LDA
#undef PG8_LDB
#undef PG8_MMA
#undef PG8_WAIT_V
#undef PG8_WAIT_L
#undef PG8_BAR
#undef PG8_SCHED
}
}

struct SchedG1 {
    const char* A; const char* B; int G, c;
    DI bool next(int i, pgx::Unit& u) const {
        int pm, pn; if (!pgx::static_tile((PROBE_REP == 11) ? (i >> 1) : i, G, c, MP / 256, ZP / 256, pm, pn)) return false;
        u.pm = pm; u.pn = pn; u.seg = 0; u.za = 0; u.nt = DM / 64; u.A = A + (size_t)pm * 256 * DM * 2; u.B = B + (size_t)pn * 256 * DM * 2; return true;
    }
};
struct EpiG1 {
    static constexpr bool PERM = true;
    bf16* Z; float* out;
    DI void operator()(const f32x4 (&acc)[2][2][4][2], const pgx::Unit& u, int wr, int wc, int fr, int fq) const {
        const int colt = u.pn * 256;
        const bool act = (colt < ZC_FA) || (colt >= ZC_GA && colt < ZC_XB) || (colt >= ZC_GB && colt < ZC_QC) || (colt >= ZC_GC);
        const float sc = (colt >= ZC_QC && colt < ZC_GC) ? QSCALE : 1.0f;
        const bool convt = (colt >= ZC_XB && colt < ZC_GB) && ((u.pm & 7) == 7);
        const int row0 = u.pm * 256 + wr * 64 + fr, col0 = colt + wc * 32 + 8 * fq;
#pragma unroll
        for (int ai = 0; ai < 2; ++ai)
#pragma unroll
            for (int m = 0; m < 4; ++m) { const int row = row0 + ai * 128 + m * 16; bf16* rowp = Z + (size_t)row * ZP + col0;
#pragma unroll
                for (int bj = 0; bj < 2; ++bj) { f32x4 v0 = acc[ai][bj][m][0], v1 = acc[ai][bj][m][1];
                    if (convt) { const int t3 = (row & 2047) - 2045; if (t3 >= 0) { float* o = out + O_CP + (size_t)((row >> 11) * 3 + t3) * 1024 + (col0 + bj * 128 - ZC_XB); *(f32x4*)o = v0; *(f32x4*)(o + 4) = v1; } }
                    if (act) { v0.x = silu(v0.x); v0.y = silu(v0.y); v0.z = silu(v0.z); v0.w = silu(v0.w); v1.x = silu(v1.x); v1.y = silu(v1.y); v1.z = silu(v1.z); v1.w = silu(v1.w); }
                    v0 = v0 * sc; v1 = v1 * sc;
                    u32x4 w; w.x = pk2(v0.x, v0.y); w.y = pk2(v0.z, v0.w); w.z = pk2(v1.x, v1.y); w.w = pk2(v1.z, v1.w);
                    *(u32x4*)(rowp + bj * 128) = w; } }
    }
};

DI void phase_g1(Ctx& c) {
    { SchedG1 S{(const char*)WSP(bf16, WS_H), (const char*)WSP(bf16, WS_WIN), c.G, c.bid}; EpiG1 E{WSP(bf16, WS_Z), c.out};
      pgx::gemm_phase(c.lds, DM, DM, DM, S, E); }
    constexpr int T_Z = (MS / 128) * (ZP / 128), T_G = (MS / 128) * 24, T_K = 16 * 4, T_V = 4 * 16;
    for (int it = c.bid; it < T_Z + T_G + T_K + T_V; it += c.G) {
        if (it < T_Z) { const int tm = it / (ZP / 128), tn = it % (ZP / 128);
            gemm_tile(c, WSP(bf16, WS_H), DM, WSP(bf16, WS_WIN), DM, DM, MP + tm * 128, tn * 128, EpiZ{WSP(bf16, WS_Z), c.out}); }
        else if (it < T_Z + T_G) { const int i = it - T_Z, tm = i / 24, tn = i % 24;
            gemm_tile(c, WSP(bf16, WS_H), DM, WSP(bf16, WS_WIN) + (size_t)5120 * DM, DM, DM, MP + tm * 128, tn * 128, EpiZGS{WSP(bf16, WS_ZGS)}); }
        else if (it < T_Z + T_G + T_K) { const int i = it - T_Z - T_G, tm = i >> 2, tn = i & 3;
            gemm_tile(c, WSP(bf16, WS_HM), DM, WSP(bf16, WS_WMEM), DM, DM, tm * 128, tn * 128, EpiMK{WSP(bf16, WS_KBP), c.out}); }
        else { const int i = it - T_Z - T_G - T_K, tm = i >> 4, tn = i & 15;
            gemm_tile(c, WSP(bf16, WS_WMEM) + (size_t)512 * DM, DM, WSP(bf16, WS_HM), DM, DM, tm * 128, tn * 128, EpiMV{WSP(bf16, WS_VTP), c.out}); }
    }
}
struct SchedG3 {
    const char* ws; int G, c;
    DI bool next(int i, pgx::Unit& u) const {
        const int r = i / 6, sg = i - 6 * r; int pm, pn; if (!pgx::static_tile((PROBE_REP == 15) ? (r >> 1) : r, G, c, MP / 256, 4, pm, pn)) return false;
        const int br = sg >> 1; u.pm = pm; u.pn = pn; u.seg = sg;
        static_assert(WS_WB == WS_WA + 2 * MiB && WS_WC == WS_WA + 4 * MiB && ZC_GB == 2 * ZC_GA && ZC_GC == 3 * ZC_GA, "branch strides");
        if ((sg & 1) == 0) { u.za = 0; u.nt = 16; u.A = ws + WS_H + (size_t)pm * 256 * DM * 2; u.B = ws + WS_WIN + (size_t)(5120 + 1024 * br + 256 * pn) * DM * 2; }
        else { u.za = 1; u.nt = (br == 1) ? 16 : 8;
            u.A = ws + WS_Z + ((size_t)pm * 256 * ZP + (size_t)ZC_GA * (br + 1)) * 2; u.B = ws + WS_WA + (size_t)br * 2 * MiB + (size_t)(256 * pn) * DM * 2; }
        return true;
    }
};
struct EpiG3 {
    static constexpr bool PERM = true;
    bf16* Z;
    DI void operator()(const f32x4 (&acc)[2][2][4][2], const pgx::Unit& u, int wr, int wc, int fr, int fq) const {
        const int row0 = u.pm * 256 + wr * 64 + fr, col0 = u.pn * 256 + wc * 32 + 8 * fq, sg = u.seg;
#pragma unroll
        for (int ai = 0; ai < 2; ++ai)
#pragma unroll
            for (int m = 0; m < 4; ++m) { bf16* rowp = Z + (size_t)(row0 + ai * 128 + m * 16) * ZP;
#pragma unroll
                for (int bj = 0; bj < 2; ++bj) { const int col = col0 + bj * 128; const int mcol = (col < 512) ? 1024 + col : 1536 + col;
                    const f32x4 v0 = acc[ai][bj][m][0], v1 = acc[ai][bj][m][1];
                    u32x4 w;
                    if ((sg & 1) == 0) { w.x = pk2(sigm(v0.x), sigm(v0.y)); w.y = pk2(sigm(v0.z), sigm(v0.w)); w.z = pk2(sigm(v1.x), sigm(v1.y)); w.w = pk2(sigm(v1.z), sigm(v1.w)); *(u32x4*)(rowp + col) = w; }
                    else {
                        float g[8], mo[8]; unpack8(*(const u32x4*)(rowp + col), g);
                        { u32x4 mw = *(const u32x4*)(rowp + mcol); if (sg == 1) mw = (u32x4){0u, 0u, 0u, 0u}; unpack8(mw, mo); }
                        w.x = pk2(mo[0] + g[0] * v0.x, mo[1] + g[1] * v0.y); w.y = pk2(mo[2] + g[2] * v0.z, mo[3] + g[3] * v0.w);
                        w.z = pk2(mo[4] + g[4] * v1.x, mo[5] + g[5] * v1.y); w.w = pk2(mo[6] + g[6] * v1.z, mo[7] + g[7] * v1.w);
                        *(u32x4*)(rowp + (sg == 5 ? col : mcol)) = w;
                    } }
                asm volatile("" ::: "memory"); }
    }
};
struct SchedG4 {
    const char* Zb; const char* WO; int G, c;
    DI bool next(int i, pgx::Unit& u) const {
        int pm, pn; if (!pgx::static_tile((PROBE_REP == 16) ? (i >> 1) : i, G, c, MP / 256, 4, pm, pn)) return false;
        u.pm = pm; u.pn = pn; u.seg = 0; u.za = 1; u.nt = 16; u.A = Zb + ((size_t)pm * 256 * ZP + ZC_MG) * 2; u.B = WO + (size_t)(256 * pn) * DM * 2; return true;
    }
};
struct EpiG4 {
    static constexpr bool PERM = false;
    const float* x; float* out;
    DI void operator()(const f32x4 (&acc)[2][2][4][2], const pgx::Unit& u, int wr, int wc, int fr, int fq) const {
        const int row0 = u.pm * 256 + wr * 64 + fr, col0 = u.pn * 256 + wc * 32 + 4 * fq;
#pragma unroll
        for (int ai = 0; ai < 2; ++ai)
#pragma unroll
            for (int m = 0; m < 4; ++m) { const size_t off = (size_t)(row0 + ai * 128 + m * 16) * DM + col0;
#pragma unroll
                for (int bj = 0; bj < 2; ++bj)
#pragma unroll
                    for (int n = 0; n < 2; ++n) { const f32x4 xv = *(const f32x4*)(x + off + bj * 128 + n * 16); *(f32x4*)(out + off + bj * 128 + n * 16) = xv + acc[ai][bj][m][n]; } }
    }
};

DI void phase_g3(Ctx& c) {
    { SchedG3 S{(const char*)c.ws, c.G, c.bid};
      EpiG3 E{WSP(bf16, WS_Z)}; pgx::gemm_phase(c.lds, DM, ZP, DM, S, E); }
    for (int it = c.bid; it < 48; it += c.G) {
        const int br = it >> 4, m0 = MP + ((it >> 3) & 1) * 128, n0 = (it & 7) * 128;
        gemm_tile(c, WSP(bf16, WS_Z) + (size_t)ZC_GA * (br + 1), ZP, WSP(bf16, WS_WA) + (size_t)br * (1024 * 1024), DM, br == 1 ? 1024 : 512, m0, n0, EpiPS{WSP(bf16, WS_ZGS), WSP(bf16, WS_PS), br});
    }
}
DI void phase_g4(Ctx& c) {
    { SchedG4 S{(const char*)WSP(bf16, WS_Z), (const char*)WSP(bf16, WS_WOUT), c.G, c.bid}; EpiG4 E{c.in[0], c.out}; pgx::gemm_phase(c.lds, DM, ZP, DM, S, E); }
    for (int it = c.bid; it < 16; it += c.G) {
        const int m0 = (it >> 3) * 128, n0 = (it & 7) * 128;
        f32x16 acc[2];
#pragma unroll
        for (int j = 0; j < 2; ++j)
#pragma unroll
            for (int i = 0; i < 16; ++i) acc[j][i] = 0.f;
        gemm_kloop<true>(c, acc, WSP(bf16, WS_PS), DM, WSP(bf16, WS_WOUT), DM, DM, m0, n0, (size_t)MS * DM);
        gemm_epi(c, acc, m0, n0, EpiYS{c.in[1], c.out});
    }
}
template <bool DUMMY> DI void phase_final(Ctx& c) {
    const int gw = c.bid * 8 + c.wave, NGW = c.G * 8;
    for (int m = gw; m < MT; m += NGW) {
        f32x4* xr = (f32x4*)(c.out + (size_t)m * DM) + c.lane; const f32x4* gr = (const f32x4*)c.in[26] + c.lane;
        f32x4 v[4]; float s = 0.f;
#pragma unroll
        for (int j = 0; j < 4; ++j) { v[j] = xr[64 * j]; s += (v[j].x * v[j].x + v[j].y * v[j].y) + (v[j].z * v[j].z + v[j].w * v[j].w); }
        const float rs = __builtin_amdgcn_rsqf(wave_sum(s) * (1.f / DM) + EPS);
        f32x4* orow = DUMMY ? (f32x4*)(c.ws + WS_Z + (size_t)m * DM * 4) + c.lane : xr;
#pragma unroll
        for (int j = 0; j < 4; ++j) { const f32x4 gg = gr[64 * j]; orow[64 * j] = v[j] * rs * gg; }
    }
}

struct ChunkHead { int m0, h, ns, tp, smp, idx; };
DI ChunkHead chunk_head(int ci) {
    ChunkHead q;
    if (ci < 1024) { q.smp = 0; q.idx = ci; q.h = ci & 3; q.m0 = (ci >> 7) * SEQ + 64 * ((ci >> 2) & 31); q.ns = 4; q.tp = 64; }
    else { const int i = ci - 1024; q.smp = 1; q.idx = i; q.h = i & 3; q.m0 = MP + (i >> 2) * DSEQ; q.ns = 2; q.tp = 32; }
    return q;
}
DI size_t vt_off(const ChunkHead& q, int v, int t) {
    const int sh = (q.tp == 64) ? 1 : 2;
    return (size_t)(q.m0 + (v >> sh)) * ZP + ZC_VA + q.h * 128 + (v & ((1 << sh) - 1)) * q.tp + t;
}
DI void hgrn_kv_round(Ctx& c, int round) {
    const int tid = c.tid, lane = c.lane, w = c.wave, g = w >> 2, kq = w & 3, r = lane & 31, hh = lane >> 5;
    const ChunkHead q = chunk_head(2 * round + g);
    bf16* Z = WSP(bf16, WS_Z);
    LAS unsigned char* LV = c.lds + g * 16384;
    { const int tg = tid & 255;
#pragma unroll
      for (int p = 0; p < 4; ++p) { const int e = p * 256 + tg, t = e >> 4, chn = e & 15;
          u32x4 v = (u32x4){0u, 0u, 0u, 0u};
          if (t < 16 * q.ns) v = *(const u32x4*)(Z + (size_t)(q.m0 + t) * ZP + ZC_VA + q.h * 128 + chn * 8);
          *(LAS u32x4*)(LV + t * 256 + chn * 16) = v; } }
    const int k = 32 * kq + r;
    const float lb = WSP(float, WS_LB)[q.h * 128 + k], olb = 1.0f - lb;
    const unsigned fo = (unsigned)(q.m0 + 8 * hh) * ZP + ZC_FA + q.h * 128 + k;
    const unsigned qo = fo - ZC_FA + ZC_QA;
    float bb[32];
#pragma unroll
    for (int s = 0; s < 4; ++s) {
        if (s < q.ns) {
#pragma unroll
            for (int j = 0; j < 8; ++j) bb[8 * s + j] = __logf(lb + olb * sigm(bf2f(Z[fo + (unsigned)((16 * s + j) * ZP)])));
        } else {
#pragma unroll
            for (int j = 0; j < 8; ++j) bb[8 * s + j] = 0.f;
        }
        asm volatile("" ::: "memory");
    }
    float off = 0.f;
#pragma unroll
    for (int s = 0; s < 4; ++s) { float run = 0.f;
#pragma unroll
        for (int j = 0; j < 8; ++j) { run += bb[8 * s + j]; bb[8 * s + j] = run; }
        const float go = __shfl_xor(run, 32), here = off + (hh ? go : 0.f);
#pragma unroll
        for (int j = 0; j < 8; ++j) bb[8 * s + j] += here;
        off += run + go; }
    const float blast = off;
    __syncthreads();
    bf16x8 af[4];
#pragma unroll
    for (int s = 0; s < 4; ++s) { float kp[8];
        if (s < q.ns) {
#pragma unroll
            for (int j = 0; j < 8; ++j) { const unsigned eo = (unsigned)((16 * s + j) * ZP); const float bv = bb[8 * s + j];
                const float om = olb * (1.0f - sigm(bf2f(Z[fo + eo]))), qv = bf2f(Z[qo + eo]);
                kp[j] = om * __expf(blast - bv);
                Z[qo + eo] = (unsigned short)(pk2(qv * __expf(bv), 0.f) & 0xffffu); Z[fo + eo] = (unsigned short)(pk2(om * __expf(-bv), 0.f) & 0xffffu); }
        } else {
#pragma unroll
            for (int j = 0; j < 8; ++j) kp[j] = 0.f;
        }
        u32x4 pw; pw.x = pk2(kp[0], kp[1]); pw.y = pk2(kp[2], kp[3]); pw.z = pk2(kp[4], kp[5]); pw.w = pk2(kp[6], kp[7]); af[s] = __builtin_bit_cast(bf16x8, pw);
        asm volatile("" ::: "memory"); }
    f32x16 acc[4];
#pragma unroll
    for (int vt = 0; vt < 4; ++vt)
#pragma unroll
        for (int i = 0; i < 16; ++i) acc[vt][i] = 0.f;
#pragma unroll
    for (int s = 0; s < 4; ++s) {
        if (s < q.ns) {
#pragma unroll
            for (int vt = 0; vt < 4; ++vt) { const LAS unsigned short* vp = (const LAS unsigned short*)(LV + (16 * s + 8 * hh) * 256 + (32 * vt + r) * 2);
                u32x4 bw; bw.x = (unsigned)vp[0] | ((unsigned)vp[128] << 16); bw.y = (unsigned)vp[256] | ((unsigned)vp[384] << 16); bw.z = (unsigned)vp[512] | ((unsigned)vp[640] << 16); bw.w = (unsigned)vp[768] | ((unsigned)vp[896] << 16);
                acc[vt] = MFMA32(af[s], __builtin_bit_cast(bf16x8, bw), acc[vt]);
                if (vt == kq) *(u32x4*)(Z + vt_off(q, 32 * vt + r, 16 * s + 8 * hh)) = bw;
                asm volatile("" ::: "memory"); }
        }
    }
    if (!q.smp) {
        bf16* STo = (bf16*)c.out + (size_t)q.idx * 16384;
#pragma unroll
        for (int vt = 0; vt < 4; ++vt)
#pragma unroll
            for (int gq = 0; gq < 4; ++gq) { u32x2 o; o.x = pk2(acc[vt][4 * gq], acc[vt][4 * gq + 1]); o.y = pk2(acc[vt][4 * gq + 2], acc[vt][4 * gq + 3]);
                *(u32x2*)(STo + (32 * vt + r) * 128 + 32 * kq + 8 * gq + 4 * hh) = o; }
        if (hh == 0) WSP(float, WS_DC)[q.idx * 128 + k] = __expf(blast);
    } else {
        LAS float* Dw = (LAS float*)(c.lds + 32768 + w * 128);
        if (hh == 0) Dw[r] = __expf(blast);
        const float* s0 = c.in[5] + (size_t)q.idx * 16384; float* sn = c.out + O_HS + (size_t)q.idx * 16384;
#pragma unroll
        for (int vt = 0; vt < 4; ++vt) {
#pragma unroll
            for (int i = 0; i < 16; ++i) { const int kk = crow(i, hh); const size_t ix = (size_t)(32 * kq + kk) * 128 + 32 * vt + r; sn[ix] = Dw[kk] * s0[ix] + acc[vt][i]; }
            asm volatile("" ::: "memory"); }
    }
    __syncthreads();
}
DI void hgrn_out_wave(Ctx& c, int ci, int tj) {
    const int lane = c.lane, r = lane & 31, hh = lane >> 5;
    const ChunkHead q = chunk_head(ci);
    bf16* Z = WSP(bf16, WS_Z);
    const bf16* STin = q.smp ? WSP(bf16, WS_ST0) + (size_t)q.idx * 16384 : (const bf16*)c.out + (size_t)q.idx * 16384;
    const int trow = q.m0 + 32 * tj + r;
    bf16x8 qgf[8];
    { const bf16* qp = Z + (size_t)trow * ZP + ZC_QA + q.h * 128 + 8 * hh;
#pragma unroll
      for (int s = 0; s < 8; ++s) qgf[s] = *(const bf16x8*)(qp + 16 * s); }
    f32x16 acc[4];
#pragma unroll
    for (int vt = 0; vt < 4; ++vt)
#pragma unroll
        for (int i = 0; i < 16; ++i) acc[vt][i] = 0.f;
#pragma unroll 1
    for (int si = 0; si <= tj; ++si) {
        f32x16 X;
#pragma unroll
        for (int i = 0; i < 16; ++i) X[i] = 0.f;
        { const bf16* kp = Z + (size_t)(q.m0 + 32 * si + r) * ZP + ZC_FA + q.h * 128 + 8 * hh;
#pragma unroll
          for (int s = 0; s < 8; ++s) X = MFMA32(*(const bf16x8*)(kp + 16 * s), qgf[s], X); }
        if (si == tj) {
#pragma unroll
            for (int i = 0; i < 16; ++i) if (crow(i, hh) > r) X[i] = 0.f;
        }
#pragma unroll
        for (int s2 = 0; s2 < 2; ++s2) {
            u32x4 pw; pw.x = pk2(X[8 * s2], X[8 * s2 + 1]); pw.y = pk2(X[8 * s2 + 2], X[8 * s2 + 3]); pw.z = pk2(X[8 * s2 + 4], X[8 * s2 + 5]); pw.w = pk2(X[8 * s2 + 6], X[8 * s2 + 7]);
            const bf16x8 pb = __builtin_bit_cast(bf16x8, pw);
#pragma unroll
            for (int vt = 0; vt < 4; ++vt) { const bf16* vp = Z + vt_off(q, 32 * vt + r, 32 * si + 16 * s2 + 4 * hh);
                const u32x2 lo = *(const u32x2*)vp, hi = *(const u32x2*)(vp + 8);
                u32x4 av; av.x = lo.x; av.y = lo.y; av.z = hi.x; av.w = hi.y; acc[vt] = MFMA32(__builtin_bit_cast(bf16x8, av), pb, acc[vt]); }
        }
    }
#pragma unroll
    for (int s = 0; s < 8; ++s) {
#pragma unroll
        for (int vt = 0; vt < 4; ++vt) acc[vt] = MFMA32(*(const bf16x8*)(STin + (32 * vt + r) * 128 + 16 * s + 8 * hh), qgf[s], acc[vt]);
        if (s == 3) asm volatile("" ::: "memory");
    }
    float ssq = 0.f;
#pragma unroll
    for (int vt = 0; vt < 4; ++vt)
#pragma unroll
        for (int i = 0; i < 16; ++i) ssq += acc[vt][i] * acc[vt][i];
    ssq += __shfl_xor(ssq, 32);
    const float rs = __builtin_amdgcn_rsqf(ssq * (1.0f / 128.0f) + EPS);
    const float* ga = c.in[11] + q.h * 128;
#pragma unroll
    for (int vt = 0; vt < 4; ++vt)
#pragma unroll
        for (int gq = 0; gq < 4; ++gq) { const int v0 = 32 * vt + 8 * gq + 4 * hh; bf16* zp = Z + (size_t)trow * ZP + ZC_GA + q.h * 128 + v0;
            float gg[4]; unpack4(*(const u32x2*)zp, gg); const f32x4 gw = *(const f32x4*)(ga + v0);
            u32x2 o; o.x = pk2(acc[vt][4 * gq] * rs * gw.x * gg[0], acc[vt][4 * gq + 1] * rs * gw.y * gg[1]); o.y = pk2(acc[vt][4 * gq + 2] * rs * gw.z * gg[2], acc[vt][4 * gq + 3] * rs * gw.w * gg[3]);
            *(u32x2*)zp = o; }
}

constexpr int NTT = SEQ / 32;
template <int MODE, bool DUMMY = false>
DI void lru_wave_item(Ctx& c, int b, int tt, int n) {
    const int lane = c.lane, w = c.wave, r = lane & 31, hh = lane >> 5;
    bf16* Z = WSP(bf16, WS_Z);
    LAS unsigned char* L = c.lds + w * 12288;
    LAS float* XCF = (LAS float*)(L + 4096);
    const int rowbase = (MODE == 2) ? MP + b * DSEQ : b * SEQ + 32 * tt;
    {
        const int t0 = 4 * (lane >> 3), g8 = lane & 7, ch = n * 64 + 8 * g8;
        float x[7][8];
#pragma unroll
        for (int i = 0; i < 7; ++i) {
            const int pos = ((MODE == 2) ? 0 : 32 * tt) + t0 + i - 3;
            if (pos >= 0) unpack8(*(const u32x4*)(Z + (size_t)(rowbase + t0 + i - 3) * ZP + ZC_XB + ch), x[i]);
            else if (MODE == 2) { const float* sc = c.in[6] + (size_t)(b * 3 + (pos + 3)) * 1024 + ch; const f32x4 a0 = *(const f32x4*)sc, a1 = *(const f32x4*)(sc + 4);
                x[i][0] = a0.x; x[i][1] = a0.y; x[i][2] = a0.z; x[i][3] = a0.w; x[i][4] = a1.x; x[i][5] = a1.y; x[i][6] = a1.z; x[i][7] = a1.w; }
            else {
#pragma unroll
                for (int q = 0; q < 8; ++q) x[i][q] = 0.f;
            }
        }
        float wv[4][8], bc[8];
        { const f32x4 b0 = *(const f32x4*)(c.in[14] + ch), b1 = *(const f32x4*)(c.in[14] + ch + 4); bc[0] = b0.x; bc[1] = b0.y; bc[2] = b0.z; bc[3] = b0.w; bc[4] = b1.x; bc[5] = b1.y; bc[6] = b1.z; bc[7] = b1.w; }
#pragma unroll
        for (int jj = 0; jj < 4; ++jj) { const f32x4 w0 = *(const f32x4*)(c.in[13] + jj * 1024 + ch), w1 = *(const f32x4*)(c.in[13] + jj * 1024 + ch + 4);
            wv[jj][0] = w0.x; wv[jj][1] = w0.y; wv[jj][2] = w0.z; wv[jj][3] = w0.w; wv[jj][4] = w1.x; wv[jj][5] = w1.y; wv[jj][6] = w1.z; wv[jj][7] = w1.w; }
#pragma unroll
        for (int tk = 0; tk < 4; ++tk) {
            float xc[8];
#pragma unroll
            for (int q = 0; q < 8; ++q) xc[q] = bc[q] + wv[0][q] * x[tk][q] + wv[1][q] * x[tk + 1][q] + wv[2][q] * x[tk + 2][q] + wv[3][q] * x[tk + 3][q];
            const int t = t0 + tk;
            *(LAS f32x4*)(XCF + t * 64 + 8 * g8) = (f32x4){xc[0], xc[1], xc[2], xc[3]}; *(LAS f32x4*)(XCF + t * 64 + 8 * g8 + 4) = (f32x4){xc[4], xc[5], xc[6], xc[7]};
            u32x4 o; o.x = pk2(xc[0], xc[1]); o.y = pk2(xc[2], xc[3]); o.z = pk2(xc[4], xc[5]); o.w = pk2(xc[6], xc[7]);
            *(LAS u32x4*)(L + swz128(t, g8)) = o;
        }
    }
#pragma unroll
    for (int ee = 0; ee < 2; ++ee) {
        const int e = 32 * ee + r, ch = n * 64 + e;
        f32x16 ar, ai;
#pragma unroll
        for (int i = 0; i < 16; ++i) { ar[i] = 0.f; ai[i] = 0.f; }
        { const bf16* Wr = WSP(bf16, WS_WLRU) + (size_t)n * 4096 + e * 64 + 8 * hh; const bf16* Wi = Wr + 65536;
#pragma unroll
          for (int s = 0; s < 4; ++s) { const bf16x8 a = *(const LAS bf16x8*)(L + swz128(r, 2 * s + hh)); ar = MFMA32(a, *(const bf16x8*)(Wr + 16 * s), ar); ai = MFMA32(a, *(const bf16x8*)(Wi + 16 * s), ai); } }
        const float sp = log1pf(__expf(-c.in[19][ch])), br_ = c.in[16][ch], bi_ = c.in[18][ch];
        float pc[16], hl[16];
#pragma unroll
        for (int g = 0; g < 4; ++g) { float pr = 1.f, hloc = 0.f;
#pragma unroll
            for (int q = 0; q < 4; ++q) { const int i = 4 * g + q, t = crow(i, hh);
                const float rg = sigm(ar[i] + br_), ig = sigm(ai[i] + bi_), xc = XCF[t * 64 + e];
                const float la = -8.0f * rg * sp, a = __expf(la);
                const float x2 = 2.0f * la;
                const float ser = -x2 * (1.0f + x2 * (0.5f + x2 * (0.16666667f + x2 * (0.041666668f + x2 * (0.0083333338f + x2 * 0.0013888889f)))));
                float mult = __builtin_amdgcn_sqrtf((x2 > -0.25f) ? ser : (1.0f - a * a));
                if (MODE != 2 && tt == 0 && t == 0) mult = 1.0f;
                hloc = a * hloc + mult * ig * xc; pr *= a; pc[i] = pr; hl[i] = hloc; } }
        float cg[4];
        float carry = (MODE == 0) ? 0.f : (MODE == 1) ? WSP(float, WS_CIN)[(size_t)(b * NTT + tt) * 1024 + ch] : c.in[7][b * 1024 + ch];
        float ptot = 1.f;
#pragma unroll
        for (int g = 0; g < 4; ++g) { const float pm = pc[4 * g + 3], hm = hl[4 * g + 3], po = __shfl_xor(pm, 32), ho = __shfl_xor(hm, 32);
            if (hh == 0) { cg[g] = carry; carry = pm * carry + hm; carry = po * carry + ho; }
            else { carry = po * carry + ho; cg[g] = carry; carry = pm * carry + hm; }
            ptot *= pm * po; }
        if (MODE == 0) { if (hh == 0) { float* ta = WSP(float, WS_TAGG) + ((size_t)(b * NTT + tt) * 1024 + ch) * 2; ta[0] = ptot; ta[1] = carry; } }
        else {
#pragma unroll
            for (int i = 0; i < 16; ++i) { const int t = crow(i, hh); const float hv = hl[i] + pc[i] * cg[i >> 2];
                bf16* zp = Z + (size_t)(rowbase + t) * ZP + ZC_GB + ch; bf16* op = DUMMY ? (bf16*)c.out + 16 * 1024 * 1024 + (size_t)(rowbase + t) * 1024 + ch : zp;
                *op = (unsigned short)(pk2(hv * bf2f(*zp), 0.f) & 0xffffu); }
            if (MODE == 2 && hh == 0) c.out[O_LS + b * 1024 + ch] = carry;
        }
    }
}

constexpr int C_K = 0, C_V = 65536;
DI int swzV(int row, int gi) { return row * 512 + (((gi >> 1) ^ (row & 15)) << 4) + (((gi & 1) ^ ((row >> 4) & 1)) << 3); }
DI void attn_item(Ctx& c, int item, bool dummy = false) {
    const int tid = c.tid, lane = c.lane, w = c.wave, r = lane & 31, hh = lane >> 5;
    LAS unsigned char* L = c.lds;
    bf16* Z = WSP(bf16, WS_Z);
    const bf16* KB; const bf16* VT; int m0, h, nw;
    if (item < 256) { const int b = item >> 5; h = (item >> 3) & 3; const int qg = item & 7; KB = WSP(bf16, WS_KBP) + (size_t)b * 256 * 512; VT = WSP(bf16, WS_VTP) + (size_t)b * 512 * 256; m0 = b * SEQ + 256 * qg + 32 * w; nw = 8; }
    else { const int i = item - 256, b = i >> 2; h = i & 3; KB = WSP(bf16, WS_KBS) + (size_t)b * 256 * 512; VT = WSP(bf16, WS_VTS) + (size_t)b * 512 * 256; m0 = MP + b * DSEQ; nw = 1; }
#pragma unroll
    for (int p = 0; p < 8; ++p) { const int e = p * 512 + tid, row = e >> 4, ch = e & 15;
        *(LAS u32x4*)(L + C_K + swz256(row, ch)) = *(const u32x4*)(KB + (size_t)row * 512 + h * 128 + ch * 8); }
    asm volatile("" ::: "memory");
#pragma unroll
    for (int p = 0; p < 8; ++p) { const int e = p * 512 + tid, row = e >> 5, ch = e & 31;
        u32x4 v = *(const u32x4*)(VT + (size_t)(h * 128 + row) * 256 + ch * 8);
        if (row & 16) v = (u32x4){v.z, v.w, v.x, v.y};
        *(LAS u32x4*)(L + C_V + row * 512 + ((ch ^ (row & 15)) << 4)) = v; }
    __syncthreads();
    if (w < nw) {
        const bf16* qp = Z + (size_t)(m0 + r) * ZP + ZC_QC + h * 128 + 8 * hh;
        f32x16 O[4];
#pragma unroll
        for (int d = 0; d < 4; ++d)
#pragma unroll
            for (int i = 0; i < 16; ++i) O[d][i] = 0.f;
        float mrun = -INFINITY, l = 0.f;
#pragma unroll 1
        for (int kc = 0; kc < 8; ++kc) {
            f32x16 S;
#pragma unroll
            for (int i = 0; i < 16; ++i) S[i] = 0.f;
            const int krow = 32 * kc + r;
#pragma unroll
            for (int s = 0; s < 8; ++s) { const bf16x8 a = *(const LAS bf16x8*)(L + C_K + swz256(krow, 2 * s + hh)); const bf16x8 qf = *(const bf16x8*)(qp + 16 * s); S = MFMA32(a, qf, S);
                if (s == 3) asm volatile("" ::: "memory"); }
            asm volatile("" ::: "memory");
            float mx = S[0];
#pragma unroll
            for (int i = 1; i < 16; ++i) mx = fmaxf(mx, S[i]);
            mx = fmaxf(mx, __shfl_xor(mx, 32));
            const float mnew = fmaxf(mrun, mx);
            const float alpha = exp2f(mrun - mnew);
            mrun = mnew; l *= alpha;
#pragma unroll
            for (int d = 0; d < 4; ++d)
#pragma unroll
                for (int i = 0; i < 16; ++i) O[d][i] *= alpha;
#pragma unroll
            for (int i = 0; i < 16; ++i) { const float pe = exp2f(S[i] - mnew); S[i] = pe; l += pe; }
#pragma unroll
            for (int s2 = 0; s2 < 2; ++s2) {
                u32x4 pw; pw.x = pk2(S[8 * s2], S[8 * s2 + 1]); pw.y = pk2(S[8 * s2 + 2], S[8 * s2 + 3]); pw.z = pk2(S[8 * s2 + 4], S[8 * s2 + 5]); pw.w = pk2(S[8 * s2 + 6], S[8 * s2 + 7]);
                const bf16x8 pb = __builtin_bit_cast(bf16x8, pw);
                const int gi = (32 * kc + 16 * s2 + 4 * hh) >> 2;
#pragma unroll
                for (int d = 0; d < 4; ++d) { const int vrow = 32 * d + r;
                    const u32x2 lo = *(const LAS u32x2*)(L + C_V + swzV(vrow, gi)), hi = *(const LAS u32x2*)(L + C_V + swzV(vrow, gi + 2));
                    u32x4 av; av.x = lo.x; av.y = lo.y; av.z = hi.x; av.w = hi.y; O[d] = MFMA32(__builtin_bit_cast(bf16x8, av), pb, O[d]); }
                asm volatile("" ::: "memory");
            }
        }
        l += __shfl_xor(l, 32);
        const float inv = frcp(l);
#pragma unroll
        for (int d = 0; d < 4; ++d)
#pragma unroll
            for (int g = 0; g < 4; ++g) { const int d0 = 32 * d + 8 * g + 4 * hh; bf16* zp = Z + (size_t)(m0 + r) * ZP + ZC_GC + h * 128 + d0;
                float gg[4]; unpack4(*(const u32x2*)zp, gg);
                u32x2 o; o.x = pk2(O[d][4 * g] * inv * gg[0], O[d][4 * g + 1] * inv * gg[1]); o.y = pk2(O[d][4 * g + 2] * inv * gg[2], O[d][4 * g + 3] * inv * gg[3]);
                bf16* op = dummy ? (bf16*)c.out + 16 * 1024 * 1024 + (size_t)(m0 + r) * 512 + h * 128 + d0 : zp;
                *(u32x2*)op = o; }
    }
    __syncthreads();
}

constexpr int N_A_R = 528, N_B_P = 1024, N_C = 256 + 32, N_A_O = 256 + 4, N_B_S = 16;
DI void phase_p2a(Ctx& c) {
    for (int it = c.bid; it < N_A_R; it += c.G) hgrn_kv_round(c, it);
    for (int it = c.bid; it < N_B_P; it += c.G) { const int wi = it * 8 + c.wave; lru_wave_item<0>(c, wi >> 10, (wi >> 4) & 63, wi & 15); }
    __syncthreads();
    for (int it = (c.bid + c.G - 16) % c.G; it < N_C; it += c.G) attn_item(c, it);
}
template <bool DUMMY> DI void phase_p2b(Ctx& c) {
    bf16* ST = (bf16*)c.out; bf16* STW = DUMMY ? ST + 16 * 1024 * 1024 : ST;
    for (int e = c.bid * 512 + c.tid; e < 131072 + 8192; e += c.G * 512) {
        if (e < 131072) {
            const int kq = e & 31, v = (e >> 5) & 127, bh = e >> 12, b = bh >> 2, h = bh & 3;
            float s[4] = {0.f, 0.f, 0.f, 0.f};
#pragma unroll 1
            for (int c0 = 0; c0 < 32; c0 += 8) {
                u32x2 kvw[8]; f32x4 dcv[8];
#pragma unroll
                for (int q = 0; q < 8; ++q) { const int item = (b * 32 + c0 + q) * 4 + h; kvw[q] = *(const u32x2*)(ST + (size_t)item * 16384 + v * 128 + kq * 4); dcv[q] = *(const f32x4*)(WSP(float, WS_DC) + item * 128 + kq * 4); }
#pragma unroll
                for (int q = 0; q < 8; ++q) { const int item = (b * 32 + c0 + q) * 4 + h; float kv[4]; unpack4(kvw[q], kv);
                    u32x2 o; o.x = pk2(s[0], s[1]); o.y = pk2(s[2], s[3]); *(u32x2*)(STW + (size_t)item * 16384 + v * 128 + kq * 4) = o;
                    s[0] = dcv[q].x * s[0] + kv[0]; s[1] = dcv[q].y * s[1] + kv[1]; s[2] = dcv[q].z * s[2] + kv[2]; s[3] = dcv[q].w * s[3] + kv[3]; }
            }
#pragma unroll
            for (int i = 0; i < 4; ++i) c.out[O_HP + ((size_t)bh * 128 + kq * 4 + i) * 128 + v] = s[i];
        } else {
            const int e2 = e - 131072, b = e2 >> 10, ch = e2 & 1023; float carry = 0.f;
#pragma unroll 1
            for (int j0 = 0; j0 < NTT; j0 += 8) {
                f32x2 ta[8];
#pragma unroll
                for (int q = 0; q < 8; ++q) ta[q] = *(const f32x2*)(WSP(float, WS_TAGG) + ((size_t)(b * NTT + j0 + q) * 1024 + ch) * 2);
#pragma unroll
                for (int q = 0; q < 8; ++q) { WSP(float, WS_CIN)[(size_t)(b * NTT + j0 + q) * 1024 + ch] = carry; carry = ta[q].x * carry + ta[q].y; }
            }
            c.out[O_LP + b * 1024 + ch] = carry;
        }
    }
}
DI void phase_p2c(Ctx& c) {
    for (int it = c.bid; it < N_A_O; it += c.G) { const int wi = it * 8 + c.wave; if (wi < 2048) hgrn_out_wave(c, wi >> 1, wi & 1); else hgrn_out_wave(c, 1024 + (wi - 2048), 0); }
    for (int it = c.bid; it < N_B_P; it += c.G) { const int wi = it * 8 + c.wave; lru_wave_item<1>(c, wi >> 10, (wi >> 4) & 63, wi & 15); }
    for (int it = (c.bid + c.G - 8) % c.G; it < N_B_S; it += c.G) { const int wi = it * 8 + c.wave; lru_wave_item<2>(c, wi >> 4, 0, wi & 15); }
    __syncthreads();
}

struct Args { const float* in[27]; float* out; unsigned char* ws; int ph_lo, ph_hi; };
constexpr int N_PHASES = 8;
__global__ void __launch_bounds__(512, 2) mk_fwd(Args a) {
    extern __shared__ __attribute__((aligned(16))) unsigned char lds_raw[];
    Ctx c;
    c.lds = (LAS unsigned char*)lds_raw;
    c.tid = threadIdx.x; c.lane = c.tid & 63; c.wave = __builtin_amdgcn_readfirstlane(c.tid >> 6);
    c.G = gridDim.x; c.bid = blockIdx.x;
#pragma unroll
    for (int i = 0; i < 27; ++i) c.in[i] = a.in[i];
    c.out = a.out; c.ws = a.ws;
    volatile LAS unsigned* MISC = (volatile LAS unsigned*)(c.lds + MISC_OFF);
    if (c.tid < 64) MISC[c.tid] = 0u;
    __syncthreads();
    XcdBarrier bar; bar.bar = (unsigned*)(a.ws + WS_CTL) + 1024; bar.x = 0; bar.st = nullptr;
    if (MK_N_LAUNCHES == 1) bar = xcd_barrier_post((unsigned*)(a.ws + WS_CTL) + 1024, MISC + 8);
    const int lo = a.ph_lo, hi = a.ph_hi;
#define IN(k) (lo <= (k) && (k) < hi)
#define SEAM(k) do { if (IN(k) && IN((k) + 1)) xcd_barrier(bar); } while (0)
#define REPS(k) ((PROBE_REP == (k)) ? (int)(c.G > 0) + 1 : 1)
    if (IN(0)) for (int rr = 0; rr < REPS(0); ++rr) { phase_prologue(c); if (rr + 1 < REPS(0)) xcd_barrier(bar); }
    SEAM(0);
    if (IN(1)) for (int rr = 0; rr < REPS(1); ++rr) { phase_g1(c); if (rr + 1 < REPS(1)) xcd_barrier(bar); }
    SEAM(1);
    if (IN(2)) phase_p2a(c);
    SEAM(2);
    if (PROBE_REP == 30) { phase_p2b<true>(c); xcd_barrier(bar); }
    if (IN(3)) phase_p2b<false>(c);
    SEAM(3);
    if (IN(4)) phase_p2c(c);
    SEAM(4);
    if (IN(5)) for (int rr = 0; rr < REPS(5); ++rr) { phase_g3(c); if (rr + 1 < REPS(5)) xcd_barrier(bar); }
    SEAM(5);
    if (IN(6)) for (int rr = 0; rr < REPS(6); ++rr) { phase_g4(c); if (rr + 1 < REPS(6)) xcd_barrier(bar); }
    SEAM(6);
    if (PROBE_REP == 80) for (int rr = 0; rr < 10; ++rr) xcd_barrier(bar);
    if (PROBE_REP == 70) { phase_final<true>(c); xcd_barrier(bar); }
    if (IN(7)) phase_final<false>(c);
#undef IN
#undef SEAM
}

extern "C" void kernel_launch(void* const* d_in, const int* in_sizes, int n_in, void* d_out, int out_size, void* d_ws, size_t ws_size, hipStream_t stream) {
    static int grid = 0;
    if (grid == 0) {
        if (n_in != 27 || ws_size < WS_END) { fprintf(stderr, "kernel_launch: unexpected n_in %d / ws_size %zu (need %zu)\n", n_in, ws_size, (size_t)WS_END); grid = -1; return; }
        int dev = 0, cus = 0, per_cu = 0;
        if (hipGetDevice(&dev) != hipSuccess || hipDeviceGetAttribute(&cus, hipDeviceAttributeMultiprocessorCount, dev) != hipSuccess) { grid = -1; return; }
        if (hipFuncSetAttribute((const void*)mk_fwd, hipFuncAttributeMaxDynamicSharedMemorySize, LDS_BYTES) != hipSuccess) { fprintf(stderr, "kernel_launch: hipFuncSetAttribute failed\n"); grid = -1; return; }
        if (hipOccupancyMaxActiveBlocksPerMultiprocessor(&per_cu, (const void*)mk_fwd, 512, LDS_BYTES) != hipSuccess || per_cu < 1) { fprintf(stderr, "kernel_launch: occupancy query says %d\n", per_cu); per_cu = 1; }
        (void)hipGetLastError();
        grid = cus;
    }
    if (grid < 0) return;
    (void)hipMemsetAsync((char*)d_ws + WS_CTL, 0, CTL_ZERO_BYTES, stream);
    Args a{};
    for (int i = 0; i < 27; ++i) a.in[i] = (const float*)d_in[i];
    a.out = (float*)d_out; a.ws = (unsigned char*)d_ws;
    if (MK_N_LAUNCHES == 1) {
        a.ph_lo = 0; a.ph_hi = N_PHASES;
        hipLaunchKernelGGL(mk_fwd, dim3(grid), dim3(512), LDS_BYTES, stream, a);
    } else {
        for (int p = 0; p < N_PHASES; ++p) { a.ph_lo = p; a.ph_hi = p + 1; hipLaunchKernelGGL(mk_fwd, dim3(grid), dim3(512), LDS_BYTES, stream, a); }
    }
}
```
